# Optimizing an MI355X kernel written in HIP

```python
import math
import jax, jax.numpy as jnp
from jax import lax
import numpy as np

D_MODEL = 2048
BATCH = 2
SEQ = 4096
DEPTH = 1

MLA_HEADS = 8
MLA_Q_RANK = 512
MLA_KV_RANK = 512
MLA_NOPE_DIM = 128
MLA_ROPE_DIM = 64
MLA_V_DIM = 128
DIFF_HEADS = 8
DIFF_QK_DIM = 64
DIFF_V_DIM = 2 * DIFF_QK_DIM
D_FF = -(-8 * D_MODEL // (3 * 256)) * 256
ROPE_THETA = 10000.0
Q_BLOCK = 128
ALPHA = (2 * DEPTH) ** 0.25
BETA = (8 * DEPTH) ** -0.25
RMS_EPS = 1e-6
SUBLN_EPS = 1e-5
LN_EPS = 1e-5

IN_SIZES = (
    MLA_Q_RANK,
    MLA_KV_RANK,
    MLA_ROPE_DIM,
    DIFF_HEADS * 2 * DIFF_QK_DIM,
    DIFF_HEADS * 2 * DIFF_QK_DIM,
    DIFF_HEADS * DIFF_V_DIM,
    D_MODEL,
    D_MODEL,
)
IN_WIDTH = sum(IN_SIZES)

kernel_name = 'hybrid_mla_diffattn_deepnorm'


def _rms_norm(x, g, eps):
    xf = x.astype(jnp.float32)
    y = xf * lax.rsqrt(jnp.mean(xf * xf, axis=-1, keepdims=True) + eps)
    return (y * g.astype(jnp.float32)).astype(x.dtype)


def _layer_norm(x, g, b):
    xf = x.astype(jnp.float32)
    mu = jnp.mean(xf, axis=-1, keepdims=True)
    xc = xf - mu
    var = jnp.mean(xc * xc, axis=-1, keepdims=True)
    y = xc * lax.rsqrt(var + LN_EPS) * g.astype(jnp.float32) + b.astype(jnp.float32)
    return y.astype(x.dtype)


def _rope_tables(seq, dim):
    inv_freq = 1.0 / (ROPE_THETA ** (jnp.arange(0, dim, 2, dtype=jnp.float32) / dim))
    ang = jnp.arange(seq, dtype=jnp.float32)[:, None] * inv_freq[None, :]
    return jnp.cos(ang), jnp.sin(ang)


def _apply_rope(x, cos, sin):
    xf = x.astype(jnp.float32)
    x1, x2 = jnp.split(xf, 2, axis=-1)
    shape = (1, cos.shape[0]) + (1,) * (x.ndim - 3) + (cos.shape[1],)
    c = cos.reshape(shape)
    s = sin.reshape(shape)
    return jnp.concatenate([x1 * c - x2 * s, x2 * c + x1 * s], axis=-1).astype(x.dtype)


def _causal_multimap_attention(q, k, v, coef, scale):
    B, S, H, M, Dk = q.shape
    Dv = v.shape[-1]
    nb = S // Q_BLOCK
    q_blocks = jnp.moveaxis(q.reshape(B, nb, Q_BLOCK, H, M, Dk), 1, 0)
    k_pos = jnp.arange(S)
    coef32 = coef.astype(jnp.float32)

    def block(args):
        qb, i = args
        s = jnp.einsum('bqhmd,bkhmd->bhmqk', qb, k,
                       preferred_element_type=jnp.float32) * scale
        q_pos = i * Q_BLOCK + jnp.arange(Q_BLOCK)
        causal = k_pos[None, :] <= q_pos[:, None]
        s = jnp.where(causal, s, -jnp.inf)
        p = jax.nn.softmax(s, axis=-1)
        w = jnp.einsum('bhmqk,m->bhqk', p, coef32)
        o = jnp.einsum('bhqk,bkhd->bqhd', w.astype(v.dtype), v,
                       preferred_element_type=jnp.float32)
        return o.astype(v.dtype)

    out = lax.map(block, (q_blocks, jnp.arange(nb)))
    return jnp.moveaxis(out, 0, 1).reshape(B, S, H, Dv)


def _mla_branch(c_q, c_kv, k_rope, q_norm_g, w_uq, kv_norm_g, w_ukv, cos, sin):
    B, S, _ = c_q.shape
    q = (_rms_norm(c_q, q_norm_g, RMS_EPS) @ w_uq).reshape(B, S, MLA_HEADS, MLA_NOPE_DIM + MLA_ROPE_DIM)
    q_nope, q_pe = jnp.split(q, [MLA_NOPE_DIM], axis=-1)
    q_pe = _apply_rope(q_pe, cos, sin)
    kv = (_rms_norm(c_kv, kv_norm_g, RMS_EPS) @ w_ukv).reshape(B, S, MLA_HEADS, MLA_NOPE_DIM + MLA_V_DIM)
    k_nope, v = jnp.split(kv, [MLA_NOPE_DIM], axis=-1)
    k_pe = _apply_rope(k_rope, cos, sin)
    k_pe = jnp.broadcast_to(k_pe[:, :, None, :], (B, S, MLA_HEADS, MLA_ROPE_DIM))
    q_full = jnp.concatenate([q_nope, q_pe], axis=-1)[:, :, :, None, :]
    k_full = jnp.concatenate([k_nope, k_pe], axis=-1)[:, :, :, None, :]
    scale = (MLA_NOPE_DIM + MLA_ROPE_DIM) ** -0.5
    out = _causal_multimap_attention(q_full, k_full, v, jnp.ones((1,), jnp.float32), scale)
    return out.reshape(B, S, MLA_HEADS * MLA_V_DIM)


def _diff_branch(dq, dk, dv, lq1, lk1, lq2, lk2, subln_g, lambda_init, cos, sin):
    B, S, _ = dq.shape
    q = _apply_rope(dq.reshape(B, S, DIFF_HEADS, 2, DIFF_QK_DIM), cos, sin)
    k = _apply_rope(dk.reshape(B, S, DIFF_HEADS, 2, DIFF_QK_DIM), cos, sin)
    v = dv.reshape(B, S, DIFF_HEADS, DIFF_V_DIM)
    lam = (jnp.exp(jnp.sum(lq1.astype(jnp.float32) * lk1.astype(jnp.float32)))
           - jnp.exp(jnp.sum(lq2.astype(jnp.float32) * lk2.astype(jnp.float32)))
           + lambda_init)
    coef = jnp.stack([jnp.ones_like(lam), -lam])
    out = _causal_multimap_attention(q, k, v, coef, DIFF_QK_DIM ** -0.5)
    out = _rms_norm(out, subln_g, SUBLN_EPS) * (1.0 - lambda_init)
    return out.reshape(B, S, DIFF_HEADS * DIFF_V_DIM)


def setup_inputs(seed: int = 0) -> dict:
    key = jax.random.key(seed)
    ks = jax.random.split(key, 20)
    f32 = jnp.float32

    def nrm(k, shape, scale):
        return jax.random.normal(k, shape, f32) * scale

    def gain(k, shape):
        return 1.0 + 0.02 * jax.random.normal(k, shape, f32)

    L = DEPTH
    mla_out = MLA_HEADS * MLA_V_DIM
    diff_out = DIFF_HEADS * DIFF_V_DIM
    return {
        'x': jax.random.normal(ks[0], (BATCH, SEQ, D_MODEL), f32),
        'w_in': nrm(ks[1], (L, D_MODEL, IN_WIDTH), D_MODEL ** -0.5),
        'mla_q_norm': gain(ks[2], (L, MLA_Q_RANK)),
        'mla_w_uq': nrm(ks[3], (L, MLA_Q_RANK, MLA_HEADS * (MLA_NOPE_DIM + MLA_ROPE_DIM)), MLA_Q_RANK ** -0.5),
        'mla_kv_norm': gain(ks[4], (L, MLA_KV_RANK)),
        'mla_w_ukv': nrm(ks[5], (L, MLA_KV_RANK, MLA_HEADS * (MLA_NOPE_DIM + MLA_V_DIM)), MLA_KV_RANK ** -0.5),
        'diff_lambda_q1': nrm(ks[6], (L, DIFF_QK_DIM), 0.1),
        'diff_lambda_k1': nrm(ks[7], (L, DIFF_QK_DIM), 0.1),
        'diff_lambda_q2': nrm(ks[8], (L, DIFF_QK_DIM), 0.1),
        'diff_lambda_k2': nrm(ks[9], (L, DIFF_QK_DIM), 0.1),
        'diff_subln': gain(ks[10], (L, DIFF_V_DIM)),
        'w_branch_a': nrm(ks[11], (L, mla_out, D_MODEL), BETA * mla_out ** -0.5),
        'w_branch_b': nrm(ks[12], (L, diff_out, D_MODEL), BETA * diff_out ** -0.5),
        'w_out': nrm(ks[13], (L, D_MODEL, D_MODEL), BETA * D_MODEL ** -0.5),
        'ln1_g': gain(ks[14], (L, D_MODEL)),
        'ln1_b': nrm(ks[15], (L, D_MODEL), 0.02),
        'w_ffn_in': nrm(ks[16], (L, D_MODEL, 2 * D_FF), D_MODEL ** -0.5),
        'w_ffn_down': nrm(ks[17], (L, D_FF, D_MODEL), BETA * D_FF ** -0.5),
        'ln2_g': gain(ks[18], (L, D_MODEL)),
        'ln2_b': nrm(ks[19], (L, D_MODEL), 0.02),
    }


def reference(x, w_in, mla_q_norm, mla_w_uq, mla_kv_norm, mla_w_ukv,
              diff_lambda_q1, diff_lambda_k1, diff_lambda_q2, diff_lambda_k2, diff_subln,
              w_branch_a, w_branch_b, w_out, ln1_g, ln1_b,
              w_ffn_in, w_ffn_down, ln2_g, ln2_b):
    S = x.shape[1]
    cos_a, sin_a = _rope_tables(S, MLA_ROPE_DIM)
    cos_b, sin_b = _rope_tables(S, DIFF_QK_DIM)
    split_at = np.cumsum(IN_SIZES)[:-1].tolist()
    h = x
    for l in range(DEPTH):
        lambda_init = 0.8 - 0.6 * math.exp(-0.3 * l)
        proj = h @ w_in[l]
        c_q, c_kv, k_rope, dq, dk, dv, g_a, g_b = jnp.split(proj, split_at, axis=-1)
        y_a = _mla_branch(c_q, c_kv, k_rope, mla_q_norm[l], mla_w_uq[l],
                          mla_kv_norm[l], mla_w_ukv[l], cos_a, sin_a) @ w_branch_a[l]
        y_b = _diff_branch(dq, dk, dv, diff_lambda_q1[l], diff_lambda_k1[l],
                           diff_lambda_q2[l], diff_lambda_k2[l], diff_subln[l],
                           lambda_init, cos_b, sin_b) @ w_branch_b[l]
        mixed = (jax.nn.sigmoid(g_a) * y_a + jax.nn.sigmoid(g_b) * y_b) @ w_out[l]
        h = _layer_norm(ALPHA * h + mixed, ln1_g[l], ln1_b[l])
        gate, up = jnp.split(h @ w_ffn_in[l], 2, axis=-1)
        ffn = (jax.nn.silu(gate) * up) @ w_ffn_down[l]
        h = _layer_norm(ALPHA * h + ffn, ln2_g[l], ln2_b[l])
    return h
```

```cpp
#include <hip/hip_runtime.h>
#include <hip/hip_cooperative_groups.h>
#include <cstdio>
#include <cstdint>
#include <cmath>
namespace cg = cooperative_groups;

#define LAS __attribute__((address_space(3)))
typedef unsigned short bf16_t;
typedef short bf16x8 __attribute__((ext_vector_type(8)));
typedef float f32x4 __attribute__((ext_vector_type(4)));
typedef float f32x2 __attribute__((ext_vector_type(2)));
typedef float f32x16 __attribute__((ext_vector_type(16)));
typedef unsigned u32x4 __attribute__((ext_vector_type(4)));
typedef unsigned u32x2 __attribute__((ext_vector_type(2)));

constexpr int T = 8192, SEQ = 4096, DM = 2048, DFF = 5632, INW = 8256;
constexpr float ALPHA = 1.189207115002721f;
constexpr float LOG2E = 1.4426950408889634f;
constexpr float QS_MLA = 0.07216878364870322f * LOG2E;
constexpr float QS_DIF = 0.125f * LOG2E;
constexpr int NWAVES = 8, NTHR = 512;
constexpr int LDS_BYTES = 131072;

constexpr size_t MiB = 1u << 20;
constexpr size_t WS_ROPE = 1 * MiB;
constexpr size_t WS_SSQ = 2 * MiB, WS_SSKV = 2 * MiB + 512 * 1024;
constexpr size_t WS_WIN = 4 * MiB;
constexpr size_t WS_WDV = 33 * MiB;
constexpr size_t WS_WUQ = 37 * MiB;
constexpr size_t WS_WUK = 39 * MiB;
constexpr size_t WS_WUV = 40 * MiB;
constexpr size_t WS_WBA = 41 * MiB, WS_WBB = 45 * MiB;
constexpr size_t WS_WOUT = 49 * MiB;
constexpr size_t WS_WFI = 57 * MiB;
constexpr size_t WS_WFD = 101 * MiB;
constexpr size_t WS_XB = 124 * MiB;
constexpr size_t WS_MLAO = 124 * MiB, WS_DIFO = 140 * MiB;
constexpr size_t WS_H1B = 124 * MiB;
constexpr size_t WS_CQ = 156 * MiB, WS_CKV = 164 * MiB;
constexpr size_t WS_QD = 172 * MiB, WS_KD = 188 * MiB, WS_VDT = 204 * MiB;
constexpr size_t WS_QM = 220 * MiB, WS_KM = 244 * MiB, WS_VMT = 268 * MiB;
constexpr size_t WS_GA = 284 * MiB, WS_GB = 316 * MiB;
constexpr size_t WS_TMP = 172 * MiB;
constexpr size_t WS_MIX = 236 * MiB;
constexpr size_t WS_PRE = 284 * MiB;
constexpr size_t WS_H1 = 172 * MiB;
constexpr size_t WS_ACT = 236 * MiB;
constexpr size_t WS_END = 352 * MiB;

struct Params {
    const float* x; const float* w_in; const float* qn; const float* w_uq; const float* kvn; const float* w_ukv;
    const float* lq1; const float* lk1; const float* lq2; const float* lk2; const float* subln;
    const float* w_ba; const float* w_bb; const float* w_out; const float* ln1g; const float* ln1b;
    const float* w_fi; const float* w_fd; const float* ln2g; const float* ln2b;
    float* out; unsigned char* ws;
    float inv_freq[32];
    int ph_lo, ph_hi;
};

typedef __bf16 bf16x2_t __attribute__((ext_vector_type(2)));
__device__ __forceinline__ unsigned cvt_pk_bf16(float lo, float hi) { f32x2 v = {lo, hi}; bf16x2_t b = __builtin_convertvector(v, bf16x2_t); return __builtin_bit_cast(unsigned, b); }
__device__ __forceinline__ u32x4 pack8(f32x4 a, f32x4 b) { u32x4 w; w.x = cvt_pk_bf16(a[0], a[1]); w.y = cvt_pk_bf16(a[2], a[3]); w.z = cvt_pk_bf16(b[0], b[1]); w.w = cvt_pk_bf16(b[2], b[3]); return w; }
__device__ __forceinline__ void unpack8(u32x4 w, f32x4& a, f32x4& b) {
    a[0] = __uint_as_float(w.x << 16); a[1] = __uint_as_float(w.x & 0xffff0000u); a[2] = __uint_as_float(w.y << 16); a[3] = __uint_as_float(w.y & 0xffff0000u);
    b[0] = __uint_as_float(w.z << 16); b[1] = __uint_as_float(w.z & 0xffff0000u); b[2] = __uint_as_float(w.w << 16); b[3] = __uint_as_float(w.w & 0xffff0000u); }
__device__ __forceinline__ float sigmoidf_(float v) { return __builtin_amdgcn_rcpf(1.0f + __builtin_amdgcn_exp2f(-v * LOG2E)); }
__device__ __forceinline__ f32x4 rope4(f32x4 v, f32x4 cs) { f32x4 o; o[0] = v[0] * cs[0] - v[1] * cs[1]; o[1] = v[1] * cs[0] + v[0] * cs[1]; o[2] = v[2] * cs[2] - v[3] * cs[3]; o[3] = v[3] * cs[2] + v[2] * cs[3]; return o; }

namespace pg8 {
constexpr int BM = 256, BK = 64, HALF = 128, HTB = HALF * BK * 2, STAGE_BYTES = 8 * HTB, NXCD = 8;
__host__ __device__ __forceinline__ int lds_byte(int r, int c) { const int st = (r >> 4) * 2 + (c >> 5), rr = r & 15, cc = c & 31, ob = rr * 64 + cc * 2; return st * 1024 + (ob ^ (((ob >> 9) & 1) << 5)); }
__host__ __device__ __forceinline__ void stage_rc(int b, int& R, int& C) { const int st = b / 1024, sb = b % 1024, swz = sb ^ (((sb >> 9) & 1) << 5); R = (st >> 1) * 16 + swz / 64; C = (st & 1) * 32 + (swz % 64) / 2; }
__host__ __device__ __forceinline__ int perm32(int rho) { const int n = rho >> 4, i = rho & 15; return 8 * (i >> 2) + 4 * n + (i & 3); }

struct Unit { int pm, pn, sel; const char* a; const char* b; };

struct SegOrder {
    const bf16_t *A0, *B0, *A1, *B1, *A2, *B2; int nM0, nN0, nM1, nN1, nM2, nN2; int nwg, G, c, K;
    __device__ __forceinline__ void init(int K_, int G_, int c_) { K = K_; G = G_; c = c_; nwg = nM0 * nN0 + nM1 * nN1 + nM2 * nN2; }
    __device__ __forceinline__ bool next(int i, Unit& u) const {
        const long L = (long)i * G + c; if (L >= nwg) return false;
        int wgid = (int)L; { const int q = nwg / NXCD, r = nwg % NXCD, xcd = wgid % NXCD, off = wgid / NXCD; wgid = (xcd < r ? xcd * (q + 1) : r * (q + 1) + (xcd - r) * q) + off; }
        int nM = nM0, nN = nN0, sel = 0; uintptr_t pa = (uintptr_t)A0, pb = (uintptr_t)B0;
        if (wgid >= nM0 * nN0) { wgid -= nM0 * nN0; nM = nM1; nN = nN1; sel = 1; pa = (uintptr_t)A1; pb = (uintptr_t)B1;
            if (wgid >= nM1 * nN1) { wgid -= nM1 * nN1; nM = nM2; nN = nN2; sel = 2; pa = (uintptr_t)A2; pb = (uintptr_t)B2; } }
        const int nig = 8 * nN, gid = wgid / nig, fm = gid * 8, gsz = (nM - fm) < 8 ? (nM - fm) : 8;
        u.pm = fm + ((wgid % nig) % gsz); u.pn = (wgid % nig) / gsz; u.sel = sel;
        u.a = (const char*)(pa + (size_t)u.pm * BM * K * 2); u.b = (const char*)(pb + (size_t)u.pn * BM * K * 2); return true;
    }
    __device__ __forceinline__ const char* A(const Unit& u) const { return u.a; }
    __device__ __forceinline__ const char* B(const Unit& u) const { return u.b; }
};
struct PairOrder {
    const bf16_t *A0, *B0, *A1, *B1; int nM, nN; int nwg, G, c, K;
    __device__ __forceinline__ void init(int K_, int G_, int c_) { K = K_; G = G_; c = c_; nwg = nM * nN; }
    __device__ __forceinline__ bool next(int i, Unit& u) const {
        const long L = (long)(i >> 1) * G + c; if (L >= nwg) return false;
        int wgid = (int)L; { const int q = nwg / NXCD, r = nwg % NXCD, xcd = wgid % NXCD, off = wgid / NXCD; wgid = (xcd < r ? xcd * (q + 1) : r * (q + 1) + (xcd - r) * q) + off; }
        const int nig = 8 * nN, gid = wgid / nig, fm = gid * 8, gsz = (nM - fm) < 8 ? (nM - fm) : 8;
        u.pm = fm + ((wgid % nig) % gsz); u.pn = (wgid % nig) / gsz; u.sel = i & 1;
        u.a = (const char*)((i & 1) ? A1 : A0) + (size_t)u.pm * BM * K * 2; u.b = (const char*)((i & 1) ? B1 : B0) + (size_t)u.pn * BM * K * 2; return true;
    }
    __device__ __forceinline__ const char* A(const Unit& u) const { return u.a; }
    __device__ __forceinline__ const char* B(const Unit& u) const { return u.b; }
};

template <class Epi, class Sched>
__device__ __forceinline__ void gemm_phase(LAS unsigned char* lds, const Sched& S, const Epi& E) {
    int tid = threadIdx.x; asm volatile("" : "+v"(tid));
    const int wid = __builtin_amdgcn_readfirstlane(tid >> 6), lane = tid & 63, wr = wid >> 2, wc = wid & 3, fr = lane & 15, fq = lane >> 4;
    const int K = S.K, nt = K / BK;
    unsigned voffA[2], voffB[2];
#pragma unroll
    for (int i = 0; i < 2; ++i) { int R, C; stage_rc(tid * 16 + i * 8192, R, C); const int Rb = (R & ~31) + perm32(R & 31);
        voffA[i] = (unsigned)(R * K + C) * 2u; voffB[i] = (unsigned)(Rb * K + C) * 2u; }
    const size_t kstep = (size_t)(BK * 2);
    const size_t hstep = (size_t)HALF * K * 2;
    const unsigned ldsw = (unsigned)wid * 1024u;
    const int aoff = lds_byte(wr * 64 + fr, fq * 8), boff = lds_byte(wc * 32 + fr, fq * 8);
#define PG8_SA(b, h) (((b) * 2 + (h)) * HTB)
#define PG8_SB(b, h) ((4 + (b) * 2 + (h)) * HTB)
#define PG8_STAGE(bufoff, gbase, voff) do { _Pragma("unroll") for (int _i = 0; _i < 2; ++_i) \
        __builtin_amdgcn_global_load_lds((const unsigned*)((const char*)(gbase) + (voff)[_i]), (LAS unsigned*)(lds + (bufoff) + ldsw + _i * 8192), 16, 0, 0); } while (0)
#define PG8_LDA(dst, b, h) do { _Pragma("unroll") for (int m = 0; m < 4; ++m) _Pragma("unroll") for (int k = 0; k < 2; ++k) dst[m][k] = *(const LAS bf16x8*)(lds + PG8_SA(b, h) + aoff + m * 2048 + k * 1024); } while (0)
#define PG8_LDB(dst, b, h) do { _Pragma("unroll") for (int n = 0; n < 2; ++n) _Pragma("unroll") for (int k = 0; k < 2; ++k) dst[n][k] = *(const LAS bf16x8*)(lds + PG8_SB(b, h) + boff + n * 2048 + k * 1024); } while (0)
#define PG8_MMA(ai, bj, At, Bt) do { __builtin_amdgcn_s_setprio(1); _Pragma("unroll") for (int m = 0; m < 4; ++m) _Pragma("unroll") for (int n = 0; n < 2; ++n) _Pragma("unroll") for (int k = 0; k < 2; ++k) \
        acc[ai][bj][m][n] = __builtin_amdgcn_mfma_f32_16x16x32_bf16(Bt[n][k], At[m][k], acc[ai][bj][m][n], 0, 0, 0); __builtin_amdgcn_s_setprio(0); } while (0)
#define PG8_WAIT_V(n) asm volatile("s_waitcnt vmcnt(" #n ")" ::: "memory")
#define PG8_WAIT_L(n) asm volatile("s_waitcnt lgkmcnt(" #n ")" ::: "memory")
#define PG8_BAR __builtin_amdgcn_s_barrier()
#define PG8_SCHED __builtin_amdgcn_sched_barrier(0)
    Unit cur, nxt; int ui = 0;
    if (!S.next(0, cur)) return;
    f32x4 acc[2][2][4][2];
#pragma unroll
    for (int a = 0; a < 2; ++a)
#pragma unroll
        for (int b = 0; b < 2; ++b)
#pragma unroll
            for (int m = 0; m < 4; ++m)
#pragma unroll
                for (int n = 0; n < 2; ++n) acc[a][b][m][n] = (f32x4){0.f, 0.f, 0.f, 0.f};
    bf16x8 At[4][2], B0[2][2], B1[2][2];
    const char* cA = S.A(cur); const char* cB = S.B(cur);
    PG8_STAGE(PG8_SB(0, 0), cB, voffB); PG8_STAGE(PG8_SB(0, 1), cB + hstep, voffB); PG8_STAGE(PG8_SA(0, 0), cA, voffA); PG8_STAGE(PG8_SA(0, 1), cA + hstep, voffA);
    if (wr == 1) PG8_BAR;
    PG8_WAIT_V(2); PG8_BAR;
    PG8_STAGE(PG8_SB(1, 0), cB + kstep, voffB); PG8_STAGE(PG8_SA(1, 0), cA + kstep, voffA); PG8_STAGE(PG8_SB(1, 1), cB + hstep + kstep, voffB);
    PG8_WAIT_V(6); PG8_BAR;
    for (;;) {
        const bool has_next = S.next(ui + 1, nxt);
        const char* nA = has_next ? S.A(nxt) : cA; const char* nB = has_next ? S.B(nxt) : cB;
        for (int t = 0; t < nt; t += 2) {
            const bool last = (t == nt - 2);
            const char* a1 = cA + (size_t)(t + 1) * kstep;
            const char* a2 = last ? nA : cA + (size_t)(t + 2) * kstep; const char* b2 = last ? nB : cB + (size_t)(t + 2) * kstep;
            const char* a3 = a2 + kstep; const char* b3 = b2 + kstep;
            PG8_LDB(B0, 0, 0); PG8_LDB(B1, 0, 1); PG8_SCHED; PG8_LDA(At, 0, 0); PG8_STAGE(PG8_SA(1, 1), a1 + hstep, voffA);
            PG8_WAIT_V(8); PG8_WAIT_L(0); PG8_BAR; PG8_MMA(0, 0, At, B0); PG8_MMA(0, 1, At, B1); PG8_BAR; PG8_SCHED;
            PG8_LDA(At, 0, 1); PG8_STAGE(PG8_SB(0, 0), b2, voffB); PG8_STAGE(PG8_SB(0, 1), b2 + hstep, voffB); PG8_STAGE(PG8_SA(0, 0), a2, voffA);
            PG8_WAIT_V(8); PG8_WAIT_L(0); PG8_BAR; PG8_MMA(1, 0, At, B0); PG8_MMA(1, 1, At, B1); PG8_BAR; PG8_SCHED;
            PG8_LDB(B0, 1, 0); PG8_LDB(B1, 1, 1); PG8_SCHED; PG8_LDA(At, 1, 0); PG8_STAGE(PG8_SA(0, 1), a2 + hstep, voffA);
            PG8_WAIT_V(8); PG8_WAIT_L(0); PG8_BAR; PG8_MMA(0, 0, At, B0); PG8_MMA(0, 1, At, B1); PG8_BAR; PG8_SCHED;
            PG8_LDA(At, 1, 1); PG8_STAGE(PG8_SB(1, 0), b3, voffB); PG8_STAGE(PG8_SB(1, 1), b3 + hstep, voffB); PG8_STAGE(PG8_SA(1, 0), a3, voffA);
            PG8_WAIT_V(8); PG8_WAIT_L(0); PG8_BAR; PG8_MMA(1, 0, At, B0); PG8_MMA(1, 1, At, B1); PG8_BAR; PG8_SCHED;
        }
        if (wr == 0) PG8_BAR;
        E(acc, cur, wr, wc, fr, fq);
        if (!has_next) break;
#pragma unroll
        for (int a = 0; a < 2; ++a)
#pragma unroll
            for (int b = 0; b < 2; ++b)
#pragma unroll
                for (int m = 0; m < 4; ++m)
#pragma unroll
                    for (int n = 0; n < 2; ++n) acc[a][b][m][n] = (f32x4){0.f, 0.f, 0.f, 0.f};
        cur = nxt; cA = nA; cB = nB; ++ui;
        if (wr == 1) PG8_BAR;
    }
    PG8_WAIT_V(0);
    PG8_BAR;
#undef PG8_SA
#undef PG8_SB
#undef PG8_STAGE
#undef PG8_LDA
#undef PG8_LDB
#undef PG8_MMA
#undef PG8_WAIT_V
#undef PG8_WAIT_L
#undef PG8_BAR
#undef PG8_SCHED
}
}
using pg8::Unit;

#define EPI_ROWS(ai, m) (row0 + (ai) * 128 + (m) * 16)
typedef const f32x4 (&AccRef)[2][2][4][2];

struct EpiP1 {
    static constexpr bool PERM = true;
    bf16_t *CQ, *CKV, *QD, *KD, *VDT, *GA, *GB, *KM; float *SSQ, *SSKV; const float* ROPE;
    __device__ __forceinline__ void operator()(AccRef acc, const Unit& u, int wr, int wc, int fr, int fq) const {
        const int row0 = u.pm * 256 + wr * 64 + fr, cl = wc * 32 + 8 * fq;
        if (u.sel == 1) {
            const int t0 = u.pn * 256 + cl;
#pragma unroll
            for (int ai = 0; ai < 2; ++ai)
#pragma unroll
                for (int m = 0; m < 4; ++m) { const int r = EPI_ROWS(ai, m);
#pragma unroll
                    for (int bj = 0; bj < 2; ++bj) { const int t = t0 + bj * 128, b = t >> 12, s = t & 4095;
                        *(u32x4*)(VDT + ((size_t)(b * 1024 + r) * 4096 + s)) = pack8(acc[ai][bj][m][0], acc[ai][bj][m][1]); } }
            return;
        }
        const int pn = u.pn;
        if (pn < 4) {
            bf16_t* dst = pn < 2 ? CQ : CKV; float* ss = pn < 2 ? SSQ : SSKV; const int colt = (pn & 1) * 256 + cl;
#pragma unroll
            for (int ai = 0; ai < 2; ++ai)
#pragma unroll
                for (int m = 0; m < 4; ++m) { const int r = EPI_ROWS(ai, m); float q = 0.f;
#pragma unroll
                    for (int bj = 0; bj < 2; ++bj) { const f32x4 v0 = acc[ai][bj][m][0], v1 = acc[ai][bj][m][1];
                        q += (v0[0] * v0[0] + v0[1] * v0[1]) + (v0[2] * v0[2] + v0[3] * v0[3]) + (v1[0] * v1[0] + v1[1] * v1[1]) + (v1[2] * v1[2] + v1[3] * v1[3]);
                        *(u32x4*)(dst + (size_t)r * 512 + colt + bj * 128) = pack8(v0, v1); }
                    q += __shfl_xor(q, 16); q += __shfl_xor(q, 32);
                    if (fq == 0) ss[(size_t)r * 8 + (pn & 1) * 4 + wc] = q; }
        } else if (pn < 12) {
            const bool isq = pn < 8; bf16_t* dst = isq ? QD : KD; const int colt = (pn - (isq ? 4 : 8)) * 256 + cl; const float sc = isq ? QS_DIF : 1.0f;
#pragma unroll
            for (int ai = 0; ai < 2; ++ai)
#pragma unroll
                for (int m = 0; m < 4; ++m) { const int r = EPI_ROWS(ai, m), pos = r & 4095;
#pragma unroll
                    for (int bj = 0; bj < 2; ++bj) { const int c = colt + bj * 128, i0 = (c & 63) >> 1;
                        const f32x4* rp = (const f32x4*)(ROPE + ((size_t)pos * 32 + i0) * 2);
                        const f32x4 v0 = rope4(acc[ai][bj][m][0], rp[0]) * sc, v1 = rope4(acc[ai][bj][m][1], rp[1]) * sc;
                        *(u32x4*)(dst + (size_t)r * 1024 + c) = pack8(v0, v1); } }
        } else if (pn < 28) {
            bf16_t* dst = pn < 20 ? GA : GB; const int colt = (pn - (pn < 20 ? 12 : 20)) * 256 + cl;
#pragma unroll
            for (int ai = 0; ai < 2; ++ai)
#pragma unroll
                for (int m = 0; m < 4; ++m) { const int r = EPI_ROWS(ai, m);
#pragma unroll
                    for (int bj = 0; bj < 2; ++bj) { f32x4 v0 = acc[ai][bj][m][0], v1 = acc[ai][bj][m][1];
#pragma unroll
                        for (int e = 0; e < 4; ++e) { v0[e] = sigmoidf_(v0[e]); v1[e] = sigmoidf_(v1[e]); }
                        *(u32x4*)(dst + (size_t)r * 2048 + colt + bj * 128) = pack8(v0, v1); } }
        } else {
            if (wc < 2) {
#pragma unroll
                for (int ai = 0; ai < 2; ++ai)
#pragma unroll
                    for (int m = 0; m < 4; ++m) { const int r = EPI_ROWS(ai, m), pos = r & 4095, i0 = cl >> 1;
                        const f32x4* rp = (const f32x4*)(ROPE + ((size_t)pos * 32 + i0) * 2);
                        const u32x4 w = pack8(rope4(acc[ai][0][m][0], rp[0]), rope4(acc[ai][0][m][1], rp[1]));
#pragma unroll
                        for (int h = 0; h < 8; ++h) *(u32x4*)(KM + ((size_t)r * 8 + h) * 192 + 128 + cl) = w; }
            }
        }
    }
};

__device__ __forceinline__ float rstd512(const float* ss, int row) { const f32x4* p = (const f32x4*)(ss + (size_t)row * 8); const f32x4 a = p[0], b = p[1];
    const float s = ((a[0] + a[1]) + (a[2] + a[3])) + ((b[0] + b[1]) + (b[2] + b[3])); return __builtin_amdgcn_rsqf(s * (1.0f / 512.0f) + 1e-6f); }

struct EpiP2 {
    static constexpr bool PERM = true;
    bf16_t *QM, *KM, *VMT; const float *SSQ, *SSKV; const float* ROPE;
    __device__ __forceinline__ void operator()(AccRef acc, const Unit& u, int wr, int wc, int fr, int fq) const {
        const int row0 = u.pm * 256 + wr * 64 + fr, cl = wc * 32 + 8 * fq;
        if (u.sel == 2) {
            const int t0 = u.pn * 256 + cl; float rs[2][8];
#pragma unroll
            for (int bj = 0; bj < 2; ++bj)
#pragma unroll
                for (int e = 0; e < 8; ++e) rs[bj][e] = rstd512(SSKV, t0 + bj * 128 + e);
#pragma unroll
            for (int ai = 0; ai < 2; ++ai)
#pragma unroll
                for (int m = 0; m < 4; ++m) { const int r = EPI_ROWS(ai, m);
#pragma unroll
                    for (int bj = 0; bj < 2; ++bj) { const int t = t0 + bj * 128, b = t >> 12, s = t & 4095; f32x4 v0 = acc[ai][bj][m][0], v1 = acc[ai][bj][m][1];
#pragma unroll
                        for (int e = 0; e < 4; ++e) { v0[e] *= rs[bj][e]; v1[e] *= rs[bj][4 + e]; }
                        *(u32x4*)(VMT + ((size_t)(b * 1024 + r) * 4096 + s)) = pack8(v0, v1); } }
            return;
        }
        const int pn = u.pn;
#pragma unroll
        for (int ai = 0; ai < 2; ++ai)
#pragma unroll
            for (int m = 0; m < 4; ++m) { const int r = EPI_ROWS(ai, m), pos = r & 4095;
                const float sc = u.sel == 0 ? rstd512(SSQ, r) * QS_MLA : rstd512(SSKV, r);
#pragma unroll
                for (int bj = 0; bj < 2; ++bj) { f32x4 v0 = acc[ai][bj][m][0], v1 = acc[ai][bj][m][1];
                    if (u.sel == 0 && pn >= 4) { const int c = (pn - 4) * 256 + cl + bj * 128, h = c >> 6, w = c & 63, i0 = w >> 1;
                        const f32x4* rp = (const f32x4*)(ROPE + ((size_t)pos * 32 + i0) * 2);
                        v0 = rope4(v0, rp[0]) * sc; v1 = rope4(v1, rp[1]) * sc;
                        *(u32x4*)(QM + ((size_t)r * 8 + h) * 192 + 128 + w) = pack8(v0, v1);
                    } else { const int c = pn * 256 + cl + bj * 128, h = c >> 7, w = c & 127; bf16_t* dst = u.sel == 0 ? QM : KM;
                        v0 = v0 * sc; v1 = v1 * sc;
                        *(u32x4*)(dst + ((size_t)r * 8 + h) * 192 + w) = pack8(v0, v1); } } }
    }
};

struct EpiP4 {
    static constexpr bool PERM = true;
    const bf16_t *GA, *GB; float* TMP; bf16_t* MIX;
    __device__ __forceinline__ void operator()(AccRef acc, const Unit& u, int wr, int wc, int fr, int fq) const {
        const int row0 = u.pm * 256 + wr * 64 + fr, col0 = u.pn * 256 + wc * 32 + 8 * fq;
#pragma unroll
        for (int ai = 0; ai < 2; ++ai)
#pragma unroll
            for (int m = 0; m < 4; ++m) { const int r = EPI_ROWS(ai, m);
#pragma unroll
                for (int bj = 0; bj < 2; ++bj) { const size_t off = (size_t)r * 2048 + col0 + bj * 128; f32x4 g0, g1;
                    unpack8(*(const u32x4*)((u.sel == 0 ? GA : GB) + off), g0, g1);
                    f32x4 v0 = acc[ai][bj][m][0] * g0, v1 = acc[ai][bj][m][1] * g1;
                    if (u.sel == 0) { *(f32x4*)(TMP + off) = v0; *(f32x4*)(TMP + off + 4) = v1; }
                    else { v0 += *(const f32x4*)(TMP + off); v1 += *(const f32x4*)(TMP + off + 4); *(u32x4*)(MIX + off) = pack8(v0, v1); } } }
    }
};
struct EpiRes {
    static constexpr bool PERM = true;
    const float* BASE; float* OUT;
    __device__ __forceinline__ void operator()(AccRef acc, const Unit& u, int wr, int wc, int fr, int fq) const {
        const int row0 = u.pm * 256 + wr * 64 + fr, col0 = u.pn * 256 + wc * 32 + 8 * fq;
#pragma unroll
        for (int ai = 0; ai < 2; ++ai)
#pragma unroll
            for (int m = 0; m < 4; ++m) { const int r = EPI_ROWS(ai, m);
#pragma unroll
                for (int bj = 0; bj < 2; ++bj) { const size_t off = (size_t)r * 2048 + col0 + bj * 128;
                    const f32x4 b0 = *(const f32x4*)(BASE + off), b1 = *(const f32x4*)(BASE + off + 4);
                    *(f32x4*)(OUT + off) = b0 * ALPHA + acc[ai][bj][m][0]; *(f32x4*)(OUT + off + 4) = b1 * ALPHA + acc[ai][bj][m][1]; } }
    }
};
struct EpiSwiGLU {
    static constexpr bool PERM = true;
    bf16_t* ACT;
    __device__ __forceinline__ void operator()(AccRef acc, const Unit& u, int wr, int wc, int fr, int fq) const {
        const int row0 = u.pm * 256 + wr * 64 + fr, col0 = u.pn * 128 + wc * 32 + 8 * fq;
#pragma unroll
        for (int ai = 0; ai < 2; ++ai)
#pragma unroll
            for (int m = 0; m < 4; ++m) { const int r = EPI_ROWS(ai, m); f32x4 v0, v1;
#pragma unroll
                for (int e = 0; e < 4; ++e) { const float g0 = acc[ai][0][m][0][e], g1 = acc[ai][0][m][1][e];
                    v0[e] = g0 * sigmoidf_(g0) * acc[ai][1][m][0][e]; v1[e] = g1 * sigmoidf_(g1) * acc[ai][1][m][1][e]; }
                *(u32x4*)(ACT + (size_t)r * DFF + col0) = pack8(v0, v1); }
    }
};

__device__ __forceinline__ unsigned f2bf(float f) { unsigned u = __builtin_bit_cast(unsigned, f); return (u + 0x7fffu + ((u >> 16) & 1u)) >> 16; }
__device__ __forceinline__ unsigned pk2(float lo, float hi) { return f2bf(lo) | (f2bf(hi) << 16); }
__device__ __forceinline__ int il64(int j) { return j < 32 ? 2 * j : 2 * (j - 32) + 1; }

__device__ __forceinline__ bf16_t* dst_row(unsigned char* ws, int mat, int c) {
    switch (mat) {
    case 0: {
        bf16_t* W = (bf16_t*)(ws + WS_WIN);
        if (c < 1024) return W + (size_t)c * 2048;
        if (c < 1088) return W + (size_t)(7168 + il64(c - 1024)) * 2048;
        if (c < 3136) { const int c2 = c - 1088; return W + (size_t)(1024 + (c2 & ~63) + il64(c2 & 63)) * 2048; }
        if (c < 4160) return (bf16_t*)(ws + WS_WDV) + (size_t)(c - 3136) * 2048;
        return W + (size_t)(3072 + (c - 4160)) * 2048; }
    case 1: {
        const int h = c / 192, w = c % 192; bf16_t* W = (bf16_t*)(ws + WS_WUQ);
        return w < 128 ? W + (size_t)(h * 128 + w) * 512 : W + (size_t)(1024 + h * 64 + il64(w - 128)) * 512; }
    case 2: {
        const int h = c >> 8, w = c & 255;
        return w < 128 ? (bf16_t*)(ws + WS_WUK) + (size_t)(h * 128 + w) * 512 : (bf16_t*)(ws + WS_WUV) + (size_t)(h * 128 + (w - 128)) * 512; }
    case 3: return (bf16_t*)(ws + WS_WBA) + (size_t)c * 1024;
    case 4: return (bf16_t*)(ws + WS_WBB) + (size_t)c * 1024;
    case 5: return (bf16_t*)(ws + WS_WOUT) + (size_t)c * 2048;
    case 6: {
        const int up = c >= DFF, cc = up ? c - DFF : c; return (bf16_t*)(ws + WS_WFI) + (size_t)((cc >> 7) * 256 + up * 128 + (cc & 127)) * 2048; }
    default: return (bf16_t*)(ws + WS_WFD) + (size_t)c * DFF;
    }
}
__device__ __forceinline__ void transpose_item(const float* W, int N, const float* gain, unsigned char* ws, int mat, LAS float* scr, int item, int lane) {
    const int nblk = N / 32, kb = item / nblk, nb = item % nblk, k0 = 64 * kb, n0 = 32 * nb;
#pragma unroll 8
    for (int i = 0; i < 32; ++i) { const int kk = 2 * i + (lane >> 5); float v = W[(size_t)(k0 + kk) * N + n0 + (lane & 31)]; if (gain) v *= gain[k0 + kk]; scr[kk * 33 + (lane & 31)] = v; }
    asm volatile("s_waitcnt lgkmcnt(0)" ::: "memory");
    const int c = lane & 7;
#pragma unroll
    for (int j = 0; j < 4; ++j) { const int n = (lane >> 3) + 8 * j; const LAS float* s = scr + (8 * c) * 33 + n;
        u32x4 o; o.x = pk2(s[0 * 33], s[1 * 33]); o.y = pk2(s[2 * 33], s[3 * 33]); o.z = pk2(s[4 * 33], s[5 * 33]); o.w = pk2(s[6 * 33], s[7 * 33]);
        *(u32x4*)(dst_row(ws, mat, n0 + n) + k0 + 8 * c) = o; }
    asm volatile("s_waitcnt lgkmcnt(0)" ::: "memory");
}
__device__ __forceinline__ void prologue(const Params& p, LAS unsigned char* lds, int tid, int wid, int lane) {
    LAS float* scr = (LAS float*)(lds + wid * 8704);
    const int gw = blockIdx.x * NWAVES + wid, NGW = gridDim.x * NWAVES;
    constexpr int I0 = 32 * 258, I1 = 8 * 48, I2 = 8 * 64, I3 = 16 * 64, I4 = 16 * 64, I5 = 32 * 64, I6 = 32 * 352, I7 = 88 * 64;
    constexpr int NITEMS = I0 + I1 + I2 + I3 + I4 + I5 + I6 + I7;
    for (int it = gw; it < NITEMS; it += NGW) {
        int r = it;
        if (r < I6) { transpose_item(p.w_fi, 2 * DFF, nullptr, p.ws, 6, scr, r, lane); continue; } r -= I6;
        if (r < I0) { transpose_item(p.w_in, INW, nullptr, p.ws, 0, scr, r, lane); continue; } r -= I0;
        if (r < I7) { transpose_item(p.w_fd, DM, nullptr, p.ws, 7, scr, r, lane); continue; } r -= I7;
        if (r < I5) { transpose_item(p.w_out, DM, nullptr, p.ws, 5, scr, r, lane); continue; } r -= I5;
        if (r < I3) { transpose_item(p.w_ba, DM, nullptr, p.ws, 3, scr, r, lane); continue; } r -= I3;
        if (r < I4) { transpose_item(p.w_bb, DM, nullptr, p.ws, 4, scr, r, lane); continue; } r -= I4;
        if (r < I1) { transpose_item(p.w_uq, 1536, p.qn, p.ws, 1, scr, r, lane); continue; } r -= I1;
        transpose_item(p.w_ukv, 2048, p.kvn, p.ws, 2, scr, r, lane);
    }
    const int gt = blockIdx.x * NTHR + tid, NGT = gridDim.x * NTHR;
    { const f32x4* xs = (const f32x4*)p.x; u32x4* xd = (u32x4*)(p.ws + WS_XB);
      for (int i = gt; i < T * DM / 8; i += NGT) { const f32x4 a = xs[2 * i], b = xs[2 * i + 1]; u32x4 o; o.x = pk2(a[0], a[1]); o.y = pk2(a[2], a[3]); o.z = pk2(b[0], b[1]); o.w = pk2(b[2], b[3]); xd[i] = o; } }
    { u32x4* z = (u32x4*)(p.ws + WS_WIN + (size_t)7232 * 2048 * 2); for (int i = gt; i < 192 * 2048 * 2 / 16; i += NGT) z[i] = (u32x4){0u, 0u, 0u, 0u}; }
    { float* rt = (float*)(p.ws + WS_ROPE);
      for (int i = gt; i < SEQ * 32; i += NGT) { const int pos = i >> 5, k = i & 31; const float ang = (float)pos * p.inv_freq[k];
          double rev = (double)ang * 0.15915494309189535; rev -= floor(rev); const float rv = (float)rev;
          rt[2 * i] = __builtin_amdgcn_cosf(rv); rt[2 * i + 1] = __builtin_amdgcn_sinf(rv); } }
}

__device__ __forceinline__ float wave_sum(float v) {
#pragma unroll
    for (int o = 1; o < 64; o <<= 1) v += __shfl_xor(v, o);
    return v;
}
template <bool BF> __device__ __forceinline__ void ln_rows(const float* in, const float* g, const float* b, float* outf, bf16_t* outb, int wid, int lane) {
    const int gw = blockIdx.x * NWAVES + wid, NGW = gridDim.x * NWAVES;
    for (int row = gw; row < T; row += NGW) {
        const f32x4* xr = (const f32x4*)(in + (size_t)row * DM) + 2 * lane;
        f32x4 v[8]; float s = 0.f;
#pragma unroll
        for (int j = 0; j < 4; ++j) { v[2 * j] = xr[128 * j]; v[2 * j + 1] = xr[128 * j + 1]; }
#pragma unroll
        for (int j = 0; j < 8; ++j) s += (v[j][0] + v[j][1]) + (v[j][2] + v[j][3]);
        const float mean = wave_sum(s) * (1.f / DM); float s2 = 0.f;
#pragma unroll
        for (int j = 0; j < 8; ++j) { v[j] = v[j] - mean; s2 += (v[j][0] * v[j][0] + v[j][1] * v[j][1]) + (v[j][2] * v[j][2] + v[j][3] * v[j][3]); }
        const float rstd = 1.0f / sqrtf(wave_sum(s2) * (1.f / DM) + 1e-5f);
#pragma unroll
        for (int j = 0; j < 4; ++j) { const int c = 512 * j + 8 * lane;
            const f32x4 g0 = *(const f32x4*)(g + c), g1 = *(const f32x4*)(g + c + 4), b0 = *(const f32x4*)(b + c), b1 = *(const f32x4*)(b + c + 4);
            const f32x4 y0 = v[2 * j] * rstd * g0 + b0, y1 = v[2 * j + 1] * rstd * g1 + b1;
            *(f32x4*)(outf + (size_t)row * DM + c) = y0; *(f32x4*)(outf + (size_t)row * DM + c + 4) = y1;
            if (BF) *(u32x4*)(outb + (size_t)row * DM + c) = pack8(y0, y1); }
    }
}

template <int DQK>
__device__ __forceinline__ void attn_pass(const bf16_t* __restrict__ Qg, int qstride, const bf16_t* __restrict__ Kg, int kstride, const bf16_t* __restrict__ Vt,
                                          int q0, LAS unsigned char* lds, f32x16 (&o)[4], int tid_in, int wid, int lane_in) {
    int tid = tid_in; asm volatile("" : "+v"(tid)); const int lane = tid & 63; (void)lane_in;
    constexpr int KROWB = DQK * 2 + 16, VROWB = 144, KBUF = 64 * KROWB, VBUF = 128 * VROWB, STAGE = KBUF + VBUF;
    constexpr int KCH = DQK / 8, NKL = (64 * KCH) / NTHR, ND = DQK / 16;
    static_assert(2 * STAGE <= LDS_BYTES && (64 * KCH) % NTHR == 0, "attention LDS");
    const int r32 = lane & 31, hi = lane >> 5;
    const int NT = (q0 + 256) >> 6;
    bf16x8 qf[ND];
    { const bf16_t* qrow = Qg + (size_t)(q0 + 32 * wid + r32) * qstride + 8 * hi;
#pragma unroll
      for (int dd = 0; dd < ND; ++dd) qf[dd] = *(const bf16x8*)(qrow + 16 * dd); }
    u32x4 kreg[NKL], vreg[2];
    unsigned kog[NKL], kol[NKL], vog[2], vol[2];
#pragma unroll
    for (int i = 0; i < NKL; ++i) { const int ch = tid + NTHR * i, kr = ch / KCH, kc = ch % KCH; kog[i] = (unsigned)(kr * kstride + kc * 8) * 2u; kol[i] = (unsigned)(kr * KROWB + kc * 16); }
#pragma unroll
    for (int i = 0; i < 2; ++i) { const int ch = tid + NTHR * i; vog[i] = (unsigned)((ch >> 3) * 4096 + (ch & 7) * 8) * 2u; vol[i] = (unsigned)(KBUF + (ch >> 3) * VROWB + (ch & 7) * 16); }
#define ATT_LOAD(j) do { const char* kb_ = (const char*)Kg + (size_t)(64 * (j)) * kstride * 2; const char* vb_ = (const char*)Vt + (size_t)(64 * (j)) * 2; \
        _Pragma("unroll") for (int i = 0; i < NKL; ++i) kreg[i] = *(const u32x4*)(kb_ + kog[i]); \
        _Pragma("unroll") for (int i = 0; i < 2; ++i) vreg[i] = *(const u32x4*)(vb_ + vog[i]); } while (0)
#define ATT_STORE(buf) do { LAS unsigned char* base_ = lds + (buf) * STAGE; \
        _Pragma("unroll") for (int i = 0; i < NKL; ++i) *(LAS u32x4*)(base_ + kol[i]) = kreg[i]; \
        _Pragma("unroll") for (int i = 0; i < 2; ++i) *(LAS u32x4*)(base_ + vol[i]) = vreg[i]; } while (0)
    float mrun = -INFINITY, lrun = 0.f;
#pragma unroll
    for (int d0 = 0; d0 < 4; ++d0)
#pragma unroll
        for (int r = 0; r < 16; ++r) o[d0][r] = 0.f;
    const int prow = ((r32 & ~12) | ((r32 & 4) << 1) | ((r32 & 8) >> 1));
    const int koff = prow * KROWB + 16 * hi, voff = KBUF + r32 * VROWB + 16 * hi;
    const int qg = q0 + 32 * wid + r32, qmaxw = q0 + 32 * wid + 31;
    ATT_LOAD(0); ATT_STORE(0); __syncthreads();
    for (int j = 0; j < NT; ++j) {
        if (j + 1 < NT) ATT_LOAD(j + 1);
        if (64 * j <= qmaxw) {
            LAS unsigned char* base = lds + (j & 1) * STAGE;
            f32x16 s0, s1;
#pragma unroll
            for (int r = 0; r < 16; ++r) { s0[r] = 0.f; s1[r] = 0.f; }
#pragma unroll
            for (int dd = 0; dd < ND; ++dd) {
                const bf16x8 k0 = *(const LAS bf16x8*)(base + koff + 32 * dd), k1 = *(const LAS bf16x8*)(base + koff + 32 * KROWB + 32 * dd);
                s0 = __builtin_amdgcn_mfma_f32_32x32x16_bf16(k0, qf[dd], s0, 0, 0, 0);
                s1 = __builtin_amdgcn_mfma_f32_32x32x16_bf16(k1, qf[dd], s1, 0, 0, 0);
                if ((dd & 3) == 3) __builtin_amdgcn_sched_barrier(0);
            }
            if (j >= NT - 4) { const int kb = 64 * j + 8 * hi;
#pragma unroll
                for (int r = 0; r < 16; ++r) { const int kv = kb + 16 * (r >> 3) + (r & 7); if (kv > qg) s0[r] = -INFINITY; if (kv + 32 > qg) s1[r] = -INFINITY; } }
            float mx = fmaxf(s0[0], s1[0]);
#pragma unroll
            for (int r = 1; r < 16; ++r) mx = fmaxf(mx, fmaxf(s0[r], s1[r]));
            mx = fmaxf(mx, __shfl_xor(mx, 32));
            const float mnew = fmaxf(mrun, mx), al = __builtin_amdgcn_exp2f(mrun - mnew); mrun = mnew;
            float ps = 0.f;
#pragma unroll
            for (int r = 0; r < 16; ++r) { s0[r] = __builtin_amdgcn_exp2f(s0[r] - mnew); s1[r] = __builtin_amdgcn_exp2f(s1[r] - mnew); ps += s0[r] + s1[r]; }
            lrun = lrun * al + ps;
#pragma unroll
            for (int d0 = 0; d0 < 4; ++d0)
#pragma unroll
                for (int r = 0; r < 16; ++r) o[d0][r] *= al;
            bf16x8 pk[4];
            { u32x4 w;
              w.x = cvt_pk_bf16(s0[0], s0[1]); w.y = cvt_pk_bf16(s0[2], s0[3]); w.z = cvt_pk_bf16(s0[4], s0[5]); w.w = cvt_pk_bf16(s0[6], s0[7]); pk[0] = __builtin_bit_cast(bf16x8, w);
              w.x = cvt_pk_bf16(s0[8], s0[9]); w.y = cvt_pk_bf16(s0[10], s0[11]); w.z = cvt_pk_bf16(s0[12], s0[13]); w.w = cvt_pk_bf16(s0[14], s0[15]); pk[1] = __builtin_bit_cast(bf16x8, w);
              w.x = cvt_pk_bf16(s1[0], s1[1]); w.y = cvt_pk_bf16(s1[2], s1[3]); w.z = cvt_pk_bf16(s1[4], s1[5]); w.w = cvt_pk_bf16(s1[6], s1[7]); pk[2] = __builtin_bit_cast(bf16x8, w);
              w.x = cvt_pk_bf16(s1[8], s1[9]); w.y = cvt_pk_bf16(s1[10], s1[11]); w.z = cvt_pk_bf16(s1[12], s1[13]); w.w = cvt_pk_bf16(s1[14], s1[15]); pk[3] = __builtin_bit_cast(bf16x8, w); }
#pragma unroll
            for (int sp = 0; sp < 4; ++sp)
#pragma unroll
                for (int d0 = 0; d0 < 4; ++d0) {
                    const bf16x8 vf = *(const LAS bf16x8*)(base + voff + d0 * 32 * VROWB + 32 * sp);
                    o[d0] = __builtin_amdgcn_mfma_f32_32x32x16_bf16(vf, pk[sp], o[d0], 0, 0, 0);
                    if (d0 == 3) __builtin_amdgcn_sched_barrier(0);
                }
        }
        if (j + 1 < NT) ATT_STORE((j + 1) & 1);
        __syncthreads();
    }
    lrun += __shfl_xor(lrun, 32);
    const float rl = 1.0f / lrun;
#pragma unroll
    for (int d0 = 0; d0 < 4; ++d0)
#pragma unroll
        for (int r = 0; r < 16; ++r) o[d0][r] *= rl;
#undef ATT_LOAD
#undef ATT_STORE
}
__device__ __forceinline__ void attn_store(const f32x16 (&o)[4], bf16_t* orow, int hi) {
#pragma unroll
    for (int d0 = 0; d0 < 4; ++d0)
#pragma unroll
        for (int g = 0; g < 4; ++g) { u32x2 w; w.x = cvt_pk_bf16(o[d0][4 * g], o[d0][4 * g + 1]); w.y = cvt_pk_bf16(o[d0][4 * g + 2], o[d0][4 * g + 3]);
            *(u32x2*)(orow + 32 * d0 + 8 * g + 4 * hi) = w; }
}
__device__ __forceinline__ void attention_phase(const Params& p, LAS unsigned char* lds, int tid, int wid, int lane) {
    const bf16_t* QM = (const bf16_t*)(p.ws + WS_QM); const bf16_t* KM = (const bf16_t*)(p.ws + WS_KM); const bf16_t* VMT = (const bf16_t*)(p.ws + WS_VMT);
    const bf16_t* QD = (const bf16_t*)(p.ws + WS_QD); const bf16_t* KD = (const bf16_t*)(p.ws + WS_KD); const bf16_t* VDT = (const bf16_t*)(p.ws + WS_VDT);
    bf16_t* MLAO = (bf16_t*)(p.ws + WS_MLAO); bf16_t* DIFO = (bf16_t*)(p.ws + WS_DIFO);
    const int r32 = lane & 31, hi = lane >> 5;
    for (int u = blockIdx.x; u < 256; u += gridDim.x) {
        const int bh = u >> 4, b = bh >> 3, h = bh & 7, qbm = u & 15, qbd = 15 - qbm;
        f32x16 o[4];
#ifndef ATTMASK
#define ATTMASK 3
#endif
        if (ATTMASK & 1) {
            const int q0 = qbm * 256;
            attn_pass<192>(QM + (size_t)b * SEQ * 1536 + h * 192, 1536, KM + (size_t)b * SEQ * 1536 + h * 192, 1536, VMT + (size_t)(b * 1024 + h * 128) * 4096, q0, lds, o, tid, wid, lane);
            attn_store(o, MLAO + (size_t)(b * SEQ + q0 + 32 * wid + r32) * 1024 + h * 128, hi);
        }
        if (ATTMASK & 2) {
            const int q0 = qbd * 256; unsigned o1p[4][8];
            attn_pass<64>(QD + (size_t)b * SEQ * 1024 + h * 128, 1024, KD + (size_t)b * SEQ * 1024 + h * 128, 1024, VDT + (size_t)(b * 1024 + h * 128) * 4096, q0, lds, o, tid, wid, lane);
#pragma unroll
            for (int d0 = 0; d0 < 4; ++d0)
#pragma unroll
                for (int r = 0; r < 8; ++r) o1p[d0][r] = cvt_pk_bf16(o[d0][2 * r], o[d0][2 * r + 1]);
            attn_pass<64>(QD + (size_t)b * SEQ * 1024 + h * 128 + 64, 1024, KD + (size_t)b * SEQ * 1024 + h * 128 + 64, 1024, VDT + (size_t)(b * 1024 + h * 128) * 4096, q0, lds, o, tid, wid, lane);
            const float lam = expf(wave_sum(p.lq1[lane] * p.lk1[lane])) - expf(wave_sum(p.lq2[lane] * p.lk2[lane])) + 0.2f;
            float ss = 0.f;
#pragma unroll
            for (int d0 = 0; d0 < 4; ++d0)
#pragma unroll
                for (int r = 0; r < 16; ++r) { const unsigned w = o1p[d0][r >> 1]; const float a1 = (r & 1) ? __uint_as_float(w & 0xffff0000u) : __uint_as_float(w << 16); const float v = a1 - lam * o[d0][r]; o[d0][r] = v; ss += v * v; }
            ss += __shfl_xor(ss, 32);
            const float rs = __builtin_amdgcn_rsqf(ss * (1.0f / 128.0f) + 1e-5f) * 0.8f;
#pragma unroll
            for (int d0 = 0; d0 < 4; ++d0)
#pragma unroll
                for (int g = 0; g < 4; ++g) { const f32x4 gv = *(const f32x4*)(p.subln + 32 * d0 + 8 * g + 4 * hi);
#pragma unroll
                    for (int e = 0; e < 4; ++e) o[d0][4 * g + e] *= rs * gv[e]; }
            attn_store(o, DIFO + (size_t)(b * SEQ + q0 + 32 * wid + r32) * 1024 + h * 128, hi);
        }
    }
}


__device__ __forceinline__ float bf2f(bf16_t v) { return __uint_as_float(((unsigned)v) << 16); }
#ifndef STOPAT
#define STOPAT 99
#endif
#define DUMP_BEGIN() const size_t NTOT_ = (size_t)T * DM; for (size_t i_ = (size_t)blockIdx.x * NTHR + threadIdx.x; i_ < NTOT_; i_ += (size_t)gridDim.x * NTHR) { float acc_ = 0.f;
#define DUMP_BF(off, n) acc_ += bf2f(((const bf16_t*)(ws + (off)))[i_ % (size_t)(n)]);
#define DUMP_F32(off, n) acc_ += ((const float*)(ws + (off)))[i_ % (size_t)(n)];
#define DUMP_END() p.out[i_] = acc_; } return;
__global__ void __launch_bounds__(NTHR, 2) fwd_megakernel(Params p) {
    extern __shared__ __attribute__((aligned(16))) unsigned char lds_raw[];
    LAS unsigned char* lds = (LAS unsigned char*)lds_raw;
    cg::grid_group grid = cg::this_grid();
    unsigned bar_phase = 0;
#define GRID_SYNC() do { asm volatile("s_waitcnt vmcnt(0) lgkmcnt(0)" ::: "memory"); __syncthreads(); \
        bar_phase += gridDim.x; \
        if (threadIdx.x == 0) { __builtin_amdgcn_fence(__ATOMIC_RELEASE, "agent"); asm volatile("s_waitcnt vmcnt(0)" ::: "memory"); \
            unsigned* ctr_ = (unsigned*)p.ws; __hip_atomic_fetch_add(ctr_, 1u, __ATOMIC_RELAXED, __HIP_MEMORY_SCOPE_AGENT); \
            while (__hip_atomic_load(ctr_, __ATOMIC_RELAXED, __HIP_MEMORY_SCOPE_AGENT) < bar_phase) __builtin_amdgcn_s_sleep(2); } \
        __syncthreads(); __builtin_amdgcn_fence(__ATOMIC_ACQUIRE, "agent"); asm volatile("s_waitcnt vmcnt(0)" ::: "memory"); } while (0)
#define IN(k) (p.ph_lo <= (k) && (k) < p.ph_hi)
    if (p.ph_hi - p.ph_lo > 1) grid.sync();
    const int tid = threadIdx.x, lane = tid & 63, wid = __builtin_amdgcn_readfirstlane(tid >> 6);
    const int G = gridDim.x, c = blockIdx.x;
    unsigned char* ws = p.ws;
    bf16_t* XB = (bf16_t*)(ws + WS_XB);
    const float* ROPE = (const float*)(ws + WS_ROPE);

    if IN(0) prologue(p, lds, tid, wid, lane);
    if (IN(0) && IN(1)) GRID_SYNC();
    if IN(1) {
        pg8::SegOrder S; S.A0 = XB; S.B0 = (const bf16_t*)(ws + WS_WIN); S.nM0 = 32; S.nN0 = 29;
        S.A1 = (const bf16_t*)(ws + WS_WDV); S.B1 = XB; S.nM1 = 4; S.nN1 = 32; S.A2 = nullptr; S.B2 = nullptr; S.nM2 = 0; S.nN2 = 0; S.init(2048, G, c);
        EpiP1 E{(bf16_t*)(ws + WS_CQ), (bf16_t*)(ws + WS_CKV), (bf16_t*)(ws + WS_QD), (bf16_t*)(ws + WS_KD), (bf16_t*)(ws + WS_VDT), (bf16_t*)(ws + WS_GA), (bf16_t*)(ws + WS_GB),
                (bf16_t*)(ws + WS_KM), (float*)(ws + WS_SSQ), (float*)(ws + WS_SSKV), ROPE};
        pg8::gemm_phase(lds, S, E);
    }
    if (IN(1) && IN(2)) GRID_SYNC();
    if IN(2) {
        pg8::SegOrder S; S.A0 = (const bf16_t*)(ws + WS_CQ); S.B0 = (const bf16_t*)(ws + WS_WUQ); S.nM0 = 32; S.nN0 = 6;
        S.A1 = (const bf16_t*)(ws + WS_CKV); S.B1 = (const bf16_t*)(ws + WS_WUK); S.nM1 = 32; S.nN1 = 4;
        S.A2 = (const bf16_t*)(ws + WS_WUV); S.B2 = (const bf16_t*)(ws + WS_CKV); S.nM2 = 4; S.nN2 = 32; S.init(512, G, c);
        EpiP2 E{(bf16_t*)(ws + WS_QM), (bf16_t*)(ws + WS_KM), (bf16_t*)(ws + WS_VMT), (const float*)(ws + WS_SSQ), (const float*)(ws + WS_SSKV), ROPE};
        pg8::gemm_phase(lds, S, E);
    }
    if (IN(2) && IN(3)) GRID_SYNC();
    if IN(3) attention_phase(p, lds, tid, wid, lane);
    if (IN(3) && IN(4)) GRID_SYNC();
    if IN(4) {
        pg8::PairOrder S; S.A0 = (const bf16_t*)(ws + WS_MLAO); S.B0 = (const bf16_t*)(ws + WS_WBA); S.A1 = (const bf16_t*)(ws + WS_DIFO); S.B1 = (const bf16_t*)(ws + WS_WBB);
        S.nM = 32; S.nN = 8; S.init(1024, G, c);
        EpiP4 E{(const bf16_t*)(ws + WS_GA), (const bf16_t*)(ws + WS_GB), (float*)(ws + WS_TMP), (bf16_t*)(ws + WS_MIX)};
        pg8::gemm_phase(lds, S, E);
    }
    if (IN(4) && IN(5)) GRID_SYNC();
    if IN(5) {
        pg8::SegOrder S; S.A0 = (const bf16_t*)(ws + WS_MIX); S.B0 = (const bf16_t*)(ws + WS_WOUT); S.nM0 = 32; S.nN0 = 8;
        S.A1 = S.B1 = S.A2 = S.B2 = nullptr; S.nM1 = S.nN1 = S.nM2 = S.nN2 = 0; S.init(2048, G, c);
        EpiRes E{p.x, (float*)(ws + WS_PRE)};
        pg8::gemm_phase(lds, S, E);
    }
    if (IN(5) && IN(6)) GRID_SYNC();
    if IN(6) ln_rows<true>((const float*)(ws + WS_PRE), p.ln1g, p.ln1b, (float*)(ws + WS_H1), (bf16_t*)(ws + WS_H1B), wid, lane);
    if (IN(6) && IN(7)) GRID_SYNC();
    if IN(7) {
        pg8::SegOrder S; S.A0 = (const bf16_t*)(ws + WS_H1B); S.B0 = (const bf16_t*)(ws + WS_WFI); S.nM0 = 32; S.nN0 = 44;
        S.A1 = S.B1 = S.A2 = S.B2 = nullptr; S.nM1 = S.nN1 = S.nM2 = S.nN2 = 0; S.init(2048, G, c);
        EpiSwiGLU E{(bf16_t*)(ws + WS_ACT)};
        pg8::gemm_phase(lds, S, E);
    }
    if (IN(7) && IN(8)) GRID_SYNC();
    if IN(8) {
        pg8::SegOrder S; S.A0 = (const bf16_t*)(ws + WS_ACT); S.B0 = (const bf16_t*)(ws + WS_WFD); S.nM0 = 32; S.nN0 = 8;
        S.A1 = S.B1 = S.A2 = S.B2 = nullptr; S.nM1 = S.nN1 = S.nM2 = S.nN2 = 0; S.init(DFF, G, c);
        EpiRes E{(const float*)(ws + WS_H1), (float*)(ws + WS_H1)};
        pg8::gemm_phase(lds, S, E);
    }
    if (IN(8) && IN(9)) GRID_SYNC();
    if IN(9) ln_rows<false>((const float*)(ws + WS_H1), p.ln2g, p.ln2b, p.out, nullptr, wid, lane);
}

extern "C" void kernel_launch(void* const* d_in, const int* in_sizes, int n_in, void* d_out, int out_size, void* d_ws, size_t ws_size, hipStream_t stream) {
    static int grid_blocks = 0;
    if (grid_blocks == 0) {
        if (n_in != 20 || in_sizes[0] != T * DM || out_size != T * DM || ws_size < WS_END) { fprintf(stderr, "kernel_launch: unexpected shapes (n_in %d, in0 %d, out %d, ws %zu)\n", n_in, n_in > 0 ? in_sizes[0] : -1, out_size, ws_size); grid_blocks = -1; return; }
        int dev = 0, cus = 0, per_cu = 0;
        (void)hipGetDevice(&dev);
        (void)hipDeviceGetAttribute(&cus, hipDeviceAttributeMultiprocessorCount, dev);
        if (hipFuncSetAttribute((const void*)fwd_megakernel, hipFuncAttributeMaxDynamicSharedMemorySize, LDS_BYTES) != hipSuccess) { fprintf(stderr, "kernel_launch: hipFuncSetAttribute failed\n"); grid_blocks = -1; return; }
        if (hipOccupancyMaxActiveBlocksPerMultiprocessor(&per_cu, (const void*)fwd_megakernel, NTHR, LDS_BYTES) != hipSuccess || per_cu < 1) { fprintf(stderr, "kernel_launch: occupancy query failed (%d)\n", per_cu); (void)hipGetLastError(); per_cu = 1; }
        grid_blocks = cus * (per_cu > 1 ? 1 : per_cu);
        if (grid_blocks > 256) grid_blocks = 256;
    }
    if (grid_blocks < 0) return;
    Params p{};
    p.x = (const float*)d_in[0]; p.w_in = (const float*)d_in[1]; p.qn = (const float*)d_in[2]; p.w_uq = (const float*)d_in[3]; p.kvn = (const float*)d_in[4]; p.w_ukv = (const float*)d_in[5];
    p.lq1 = (const float*)d_in[6]; p.lk1 = (const float*)d_in[7]; p.lq2 = (const float*)d_in[8]; p.lk2 = (const float*)d_in[9]; p.subln = (const float*)d_in[10];
    p.w_ba = (const float*)d_in[11]; p.w_bb = (const float*)d_in[12]; p.w_out = (const float*)d_in[13]; p.ln1g = (const float*)d_in[14]; p.ln1b = (const float*)d_in[15];
    p.w_fi = (const float*)d_in[16]; p.w_fd = (const float*)d_in[17]; p.ln2g = (const float*)d_in[18]; p.ln2b = (const float*)d_in[19];
    p.out = (float*)d_out; p.ws = (unsigned char*)d_ws;
    for (int i = 0; i < 32; ++i) p.inv_freq[i] = 1.0f / powf(10000.0f, (float)(2 * i) / 64.0f);
    if (hipMemsetAsync(d_ws, 0, 256, stream) != hipSuccess) { fprintf(stderr, "kernel_launch: memset failed\n"); return; }
#ifndef MK_LAUNCHES
#define MK_LAUNCHES 1
#endif
    for (int li = 0; li < MK_LAUNCHES; ++li) {
        p.ph_lo = (MK_LAUNCHES == 1) ? 0 : li; p.ph_hi = (MK_LAUNCHES == 1) ? 10 : li + 1;
        void* args[] = {&p};
        hipError_t e = hipLaunchCooperativeKernel((const void*)fwd_megakernel, dim3(grid_blocks), dim3(NTHR), args, LDS_BYTES, stream);
        if (e != hipSuccess) { fprintf(stderr, "cooperative launch failed: %s (grid %d)\n", hipGetErrorString(e), grid_blocks); break; }
    }
}
```

```cpp
#include <hip/hip_runtime.h>
#include <hip/hip_cooperative_groups.h>
#include <cstdio>
#include <cstdint>
#include <cmath>
namespace cg = cooperative_groups;

#define LAS __attribute__((address_space(3)))
typedef unsigned short bf16_t;
typedef short bf16x8 __attribute__((ext_vector_type(8)));
typedef float f32x4 __attribute__((ext_vector_type(4)));
typedef float f32x2 __attribute__((ext_vector_type(2)));
typedef float f32x16 __attribute__((ext_vector_type(16)));
typedef unsigned u32x4 __attribute__((ext_vector_type(4)));
typedef unsigned u32x2 __attribute__((ext_vector_type(2)));

constexpr int T = 8192, SEQ = 4096, DM = 2048, DFF = 5632, INW = 8256;
constexpr float ALPHA = 1.189207115002721f;
constexpr float LOG2E = 1.4426950408889634f;
constexpr float QS_MLA = 0.07216878364870322f * LOG2E;
constexpr float QS_DIF = 0.125f * LOG2E;
constexpr int NWAVES = 8, NTHR = 512;
constexpr int LDS_BYTES = 131072 + 64;

constexpr size_t MiB = 1u << 20;
constexpr size_t WS_ROPE = 1 * MiB;
constexpr size_t WS_SSQ = 2 * MiB, WS_SSKV = 2 * MiB + 512 * 1024;
constexpr size_t WS_WIN = 4 * MiB;
constexpr size_t WS_WDV = 33 * MiB;
constexpr size_t WS_WUQ = 37 * MiB;
constexpr size_t WS_WUK = 39 * MiB;
constexpr size_t WS_WUV = 40 * MiB;
constexpr size_t WS_WBA = 41 * MiB, WS_WBB = 45 * MiB;
constexpr size_t WS_WOUT = 49 * MiB;
constexpr size_t WS_WFI = 57 * MiB;
constexpr size_t WS_WFD = 101 * MiB;
constexpr size_t WS_XB = 124 * MiB;
constexpr size_t WS_MLAO = 124 * MiB, WS_DIFO = 140 * MiB;
constexpr size_t WS_H1B = 124 * MiB;
constexpr size_t WS_CQ = 156 * MiB, WS_CKV = 164 * MiB;
constexpr size_t WS_QD = 172 * MiB, WS_KD = 188 * MiB, WS_VDT = 204 * MiB;
constexpr size_t WS_QM = 220 * MiB, WS_KM = 244 * MiB, WS_VMT = 268 * MiB;
constexpr size_t WS_GA = 284 * MiB, WS_GB = 316 * MiB;
constexpr size_t WS_TMP = 172 * MiB;
constexpr size_t WS_MIX = 236 * MiB;
constexpr size_t WS_PRE = 284 * MiB;
constexpr size_t WS_H1 = 172 * MiB;
constexpr size_t WS_ACT = 236 * MiB;
constexpr size_t WS_END = 352 * MiB;

struct Params {
    const float* x; const float* w_in; const float* qn; const float* w_uq; const float* kvn; const float* w_ukv;
    const float* lq1; const float* lk1; const float* lq2; const float* lk2; const float* subln;
    const float* w_ba; const float* w_bb; const float* w_out; const float* ln1g; const float* ln1b;
    const float* w_fi; const float* w_fd; const float* ln2g; const float* ln2b;
    float* out; unsigned char* ws;
    float inv_freq[32];
    int ph_lo, ph_hi;
};

typedef __bf16 bf16x2_t __attribute__((ext_vector_type(2)));
__device__ __forceinline__ unsigned cvt_pk_bf16(float lo, float hi) { f32x2 v = {lo, hi}; bf16x2_t b = __builtin_convertvector(v, bf16x2_t); return __builtin_bit_cast(unsigned, b); }
__device__ __forceinline__ u32x4 pack8(f32x4 a, f32x4 b) { u32x4 w; w.x = cvt_pk_bf16(a[0], a[1]); w.y = cvt_pk_bf16(a[2], a[3]); w.z = cvt_pk_bf16(b[0], b[1]); w.w = cvt_pk_bf16(b[2], b[3]); return w; }
__device__ __forceinline__ void unpack8(u32x4 w, f32x4& a, f32x4& b) {
    a[0] = __uint_as_float(w.x << 16); a[1] = __uint_as_float(w.x & 0xffff0000u); a[2] = __uint_as_float(w.y << 16); a[3] = __uint_as_float(w.y & 0xffff0000u);
    b[0] = __uint_as_float(w.z << 16); b[1] = __uint_as_float(w.z & 0xffff0000u); b[2] = __uint_as_float(w.w << 16); b[3] = __uint_as_float(w.w & 0xffff0000u); }
__device__ __forceinline__ float sigmoidf_(float v) { return __builtin_amdgcn_rcpf(1.0f + __builtin_amdgcn_exp2f(-v * LOG2E)); }
__device__ __forceinline__ f32x4 rope4(f32x4 v, f32x4 cs) { f32x4 o; o[0] = v[0] * cs[0] - v[1] * cs[1]; o[1] = v[1] * cs[0] + v[0] * cs[1]; o[2] = v[2] * cs[2] - v[3] * cs[3]; o[3] = v[3] * cs[2] + v[2] * cs[3]; return o; }

namespace pg8 {
constexpr int BM = 256, BK = 64, HALF = 128, HTB = HALF * BK * 2, STAGE_BYTES = 8 * HTB, NXCD = 8;
__host__ __device__ __forceinline__ int lds_byte(int r, int c) { const int st = (r >> 4) * 2 + (c >> 5), rr = r & 15, cc = c & 31, ob = rr * 64 + cc * 2; return st * 1024 + (ob ^ (((ob >> 9) & 1) << 5)); }
__host__ __device__ __forceinline__ void stage_rc(int b, int& R, int& C) { const int st = b / 1024, sb = b % 1024, swz = sb ^ (((sb >> 9) & 1) << 5); R = (st >> 1) * 16 + swz / 64; C = (st & 1) * 32 + (swz % 64) / 2; }
__host__ __device__ __forceinline__ int perm32(int rho) { const int n = rho >> 4, i = rho & 15; return 8 * (i >> 2) + 4 * n + (i & 3); }

struct Unit { int pm, pn, sel; const char* a; const char* b; };

struct SegOrder {
    const bf16_t *A0, *B0, *A1, *B1, *A2, *B2; int nM0, nN0, nM1, nN1, nM2, nN2; int nwg, G, c, K;
    __device__ __forceinline__ void init(int K_, int G_, int c_) { K = K_; G = G_; c = c_; nwg = nM0 * nN0 + nM1 * nN1 + nM2 * nN2; }
    __device__ __forceinline__ bool next(int i, Unit& u) const {
        const long L = (long)i * G + c; if (L >= nwg) return false;
        int wgid = (int)L; { const int q = nwg / NXCD, r = nwg % NXCD, xcd = wgid % NXCD, off = wgid / NXCD; wgid = (xcd < r ? xcd * (q + 1) : r * (q + 1) + (xcd - r) * q) + off; }
        int nM = nM0, nN = nN0, sel = 0; uintptr_t pa = (uintptr_t)A0, pb = (uintptr_t)B0;
        if (wgid >= nM0 * nN0) { wgid -= nM0 * nN0; nM = nM1; nN = nN1; sel = 1; pa = (uintptr_t)A1; pb = (uintptr_t)B1;
            if (wgid >= nM1 * nN1) { wgid -= nM1 * nN1; nM = nM2; nN = nN2; sel = 2; pa = (uintptr_t)A2; pb = (uintptr_t)B2; } }
        const int nig = 8 * nN, gid = wgid / nig, fm = gid * 8, gsz = (nM - fm) < 8 ? (nM - fm) : 8;
        u.pm = fm + ((wgid % nig) % gsz); u.pn = (wgid % nig) / gsz; u.sel = sel;
        u.a = (const char*)(pa + (size_t)u.pm * BM * K * 2); u.b = (const char*)(pb + (size_t)u.pn * BM * K * 2); return true;
    }
    __device__ __forceinline__ const char* A(const Unit& u) const { return u.a; }
    __device__ __forceinline__ const char* B(const Unit& u) const { return u.b; }
};
struct PairOrder {
    const bf16_t *A0, *B0, *A1, *B1; int nM, nN; int nwg, G, c, K;
    __device__ __forceinline__ void init(int K_, int G_, int c_) { K = K_; G = G_; c = c_; nwg = nM * nN; }
    __device__ __forceinline__ bool next(int i, Unit& u) const {
        const long L = (long)(i >> 1) * G + c; if (L >= nwg) return false;
        int wgid = (int)L; { const int q = nwg / NXCD, r = nwg % NXCD, xcd = wgid % NXCD, off = wgid / NXCD; wgid = (xcd < r ? xcd * (q + 1) : r * (q + 1) + (xcd - r) * q) + off; }
        const int nig = 8 * nN, gid = wgid / nig, fm = gid * 8, gsz = (nM - fm) < 8 ? (nM - fm) : 8;
        u.pm = fm + ((wgid % nig) % gsz); u.pn = (wgid % nig) / gsz; u.sel = i & 1;
        u.a = (const char*)((i & 1) ? A1 : A0) + (size_t)u.pm * BM * K * 2; u.b = (const char*)((i & 1) ? B1 : B0) + (size_t)u.pn * BM * K * 2; return true;
    }
    __device__ __forceinline__ const char* A(const Unit& u) const { return u.a; }
    __device__ __forceinline__ const char* B(const Unit& u) const { return u.b; }
};

template <class Epi, class Sched>
__device__ __forceinline__ void gemm_phase(LAS unsigned char* lds, const Sched& S, const Epi& E) {
    int tid = threadIdx.x; asm volatile("" : "+v"(tid));
    const int wid = __builtin_amdgcn_readfirstlane(tid >> 6), lane = tid & 63, wr = wid >> 2, wc = wid & 3, fr = lane & 15, fq = lane >> 4;
    const int K = S.K, nt = K / BK;
    unsigned voffA[2], voffB[2];
#pragma unroll
    for (int i = 0; i < 2; ++i) { int R, C; stage_rc(tid * 16 + i * 8192, R, C); const int Rb = (R & ~31) + perm32(R & 31);
        voffA[i] = (unsigned)(R * K + C) * 2u; voffB[i] = (unsigned)(Rb * K + C) * 2u; }
    const size_t kstep = (size_t)(BK * 2);
    const size_t hstep = (size_t)HALF * K * 2;
    const unsigned ldsw = (unsigned)wid * 1024u;
    const int aoff = lds_byte(wr * 64 + fr, fq * 8), boff = lds_byte(wc * 32 + fr, fq * 8);
#define PG8_SA(b, h) (((b) * 2 + (h)) * HTB)
#define PG8_SB(b, h) ((4 + (b) * 2 + (h)) * HTB)
#define PG8_STAGE(bufoff, gbase, voff) do { _Pragma("unroll") for (int _i = 0; _i < 2; ++_i) \
        __builtin_amdgcn_global_load_lds((const unsigned*)((const char*)(gbase) + (voff)[_i]), (LAS unsigned*)(lds + (bufoff) + ldsw + _i * 8192), 16, 0, 0); } while (0)
#define PG8_LDA(dst, b, h) do { _Pragma("unroll") for (int m = 0; m < 4; ++m) _Pragma("unroll") for (int k = 0; k < 2; ++k) dst[m][k] = *(const LAS bf16x8*)(lds + PG8_SA(b, h) + aoff + m * 2048 + k * 1024); } while (0)
#define PG8_LDB(dst, b, h) do { _Pragma("unroll") for (int n = 0; n < 2; ++n) _Pragma("unroll") for (int k = 0; k < 2; ++k) dst[n][k] = *(const LAS bf16x8*)(lds + PG8_SB(b, h) + boff + n * 2048 + k * 1024); } while (0)
#define PG8_MMA(ai, bj, At, Bt) do { __builtin_amdgcn_s_setprio(1); _Pragma("unroll") for (int m = 0; m < 4; ++m) _Pragma("unroll") for (int n = 0; n < 2; ++n) _Pragma("unroll") for (int k = 0; k < 2; ++k) \
        acc[ai][bj][m][n] = __builtin_amdgcn_mfma_f32_16x16x32_bf16(Bt[n][k], At[m][k], acc[ai][bj][m][n], 0, 0, 0); __builtin_amdgcn_s_setprio(0); } while (0)
#define PG8_WAIT_V(n) asm volatile("s_waitcnt vmcnt(" #n ")" ::: "memory")
#define PG8_WAIT_L(n) asm volatile("s_waitcnt lgkmcnt(" #n ")" ::: "memory")
#define PG8_BAR __builtin_amdgcn_s_barrier()
#define PG8_SCHED __builtin_amdgcn_sched_barrier(0)
    Unit cur, nxt; int ui = 0;
    if (!S.next(0, cur)) return;
    f32x4 acc[2][2][4][2];
#pragma unroll
    for (int a = 0; a < 2; ++a)
#pragma unroll
        for (int b = 0; b < 2; ++b)
#pragma unroll
            for (int m = 0; m < 4; ++m)
#pragma unroll
                for (int n = 0; n < 2; ++n) acc[a][b][m][n] = (f32x4){0.f, 0.f, 0.f, 0.f};
    bf16x8 At[4][2], B0[2][2], B1[2][2];
    const char* cA = S.A(cur); const char* cB = S.B(cur);
    PG8_STAGE(PG8_SB(0, 0), cB, voffB); PG8_STAGE(PG8_SB(0, 1), cB + hstep, voffB); PG8_STAGE(PG8_SA(0, 0), cA, voffA); PG8_STAGE(PG8_SA(0, 1), cA + hstep, voffA);
    if (wr == 1) PG8_BAR;
    PG8_WAIT_V(2); PG8_BAR;
    PG8_STAGE(PG8_SB(1, 0), cB + kstep, voffB); PG8_STAGE(PG8_SA(1, 0), cA + kstep, voffA); PG8_STAGE(PG8_SB(1, 1), cB + hstep + kstep, voffB);
    PG8_WAIT_V(6); PG8_BAR;
    for (;;) {
        const bool has_next = S.next(ui + 1, nxt);
        const char* nA = has_next ? S.A(nxt) : cA; const char* nB = has_next ? S.B(nxt) : cB;
        for (int t = 0; t < nt; t += 2) {
            const bool last = (t == nt - 2);
            const char* a1 = cA + (size_t)(t + 1) * kstep;
            const char* a2 = last ? nA : cA + (size_t)(t + 2) * kstep; const char* b2 = last ? nB : cB + (size_t)(t + 2) * kstep;
            const char* a3 = a2 + kstep; const char* b3 = b2 + kstep;
            PG8_LDB(B0, 0, 0); PG8_LDB(B1, 0, 1); PG8_SCHED; PG8_LDA(At, 0, 0); PG8_STAGE(PG8_SA(1, 1), a1 + hstep, voffA);
            PG8_WAIT_V(8); PG8_WAIT_L(0); PG8_BAR; PG8_MMA(0, 0, At, B0); PG8_MMA(0, 1, At, B1); PG8_BAR; PG8_SCHED;
            PG8_LDA(At, 0, 1); PG8_STAGE(PG8_SB(0, 0), b2, voffB); PG8_STAGE(PG8_SB(0, 1), b2 + hstep, voffB); PG8_STAGE(PG8_SA(0, 0), a2, voffA);
            PG8_WAIT_V(8); PG8_WAIT_L(0); PG8_BAR; PG8_MMA(1, 0, At, B0); PG8_MMA(1, 1, At, B1); PG8_BAR; PG8_SCHED;
            PG8_LDB(B0, 1, 0); PG8_LDB(B1, 1, 1); PG8_SCHED; PG8_LDA(At, 1, 0); PG8_STAGE(PG8_SA(0, 1), a2 + hstep, voffA);
            PG8_WAIT_V(8); PG8_WAIT_L(0); PG8_BAR; PG8_MMA(0, 0, At, B0); PG8_MMA(0, 1, At, B1); PG8_BAR; PG8_SCHED;
            PG8_LDA(At, 1, 1); PG8_STAGE(PG8_SB(1, 0), b3, voffB); PG8_STAGE(PG8_SB(1, 1), b3 + hstep, voffB); PG8_STAGE(PG8_SA(1, 0), a3, voffA);
            PG8_WAIT_V(8); PG8_WAIT_L(0); PG8_BAR; PG8_MMA(1, 0, At, B0); PG8_MMA(1, 1, At, B1); PG8_BAR; PG8_SCHED;
        }
        if (wr == 0) PG8_BAR;
        E(acc, cur, wr, wc, fr, fq);
        if (!has_next) break;
#pragma unroll
        for (int a = 0; a < 2; ++a)
#pragma unroll
            for (int b = 0; b < 2; ++b)
#pragma unroll
                for (int m = 0; m < 4; ++m)
#pragma unroll
                    for (int n = 0; n < 2; ++n) acc[a][b][m][n] = (f32x4){0.f, 0.f, 0.f, 0.f};
        cur = nxt; cA = nA; cB = nB; ++ui;
        if (wr == 1) PG8_BAR;
    }
    PG8_WAIT_V(0);
    PG8_BAR;
#undef PG8_SA
#undef PG8_SB
#undef PG8_STAGE
#undef PG8_LDA
#undef PG8_LDB
#undef PG8_MMA
#undef PG8_WAIT_V
#undef PG8_WAIT_L
#undef PG8_BAR
#undef PG8_SCHED
}
}
using pg8::Unit;

#define EPI_ROWS(ai, m) (row0 + (ai) * 128 + (m) * 16)
typedef const f32x4 (&AccRef)[2][2][4][2];

struct EpiP1 {
    static constexpr bool PERM = true;
    bf16_t *CQ, *CKV, *QD, *KD, *VDT, *GA, *GB, *KM; float *SSQ, *SSKV; const float* ROPE;
    __device__ __forceinline__ void operator()(AccRef acc, const Unit& u, int wr, int wc, int fr, int fq) const {
        const int row0 = u.pm * 256 + wr * 64 + fr, cl = wc * 32 + 8 * fq;
        if (u.sel == 1) {
            const int t0 = u.pn * 256 + cl;
#pragma unroll
            for (int ai = 0; ai < 2; ++ai)
#pragma unroll
                for (int m = 0; m < 4; ++m) { const int r = EPI_ROWS(ai, m);
#pragma unroll
                    for (int bj = 0; bj < 2; ++bj) { const int t = t0 + bj * 128, b = t >> 12, s = t & 4095;
                        *(u32x4*)(VDT + ((size_t)(b * 1024 + r) * 4096 + s)) = pack8(acc[ai][bj][m][0], acc[ai][bj][m][1]); } }
            return;
        }
        const int pn = u.pn;
        if (pn < 4) {
            bf16_t* dst = pn < 2 ? CQ : CKV; float* ss = pn < 2 ? SSQ : SSKV; const int colt = (pn & 1) * 256 + cl;
#pragma unroll
            for (int ai = 0; ai < 2; ++ai)
#pragma unroll
                for (int m = 0; m < 4; ++m) { const int r = EPI_ROWS(ai, m); float q = 0.f;
#pragma unroll
                    for (int bj = 0; bj < 2; ++bj) { const f32x4 v0 = acc[ai][bj][m][0], v1 = acc[ai][bj][m][1];
                        q += (v0[0] * v0[0] + v0[1] * v0[1]) + (v0[2] * v0[2] + v0[3] * v0[3]) + (v1[0] * v1[0] + v1[1] * v1[1]) + (v1[2] * v1[2] + v1[3] * v1[3]);
                        *(u32x4*)(dst + (size_t)r * 512 + colt + bj * 128) = pack8(v0, v1); }
                    q += __shfl_xor(q, 16); q += __shfl_xor(q, 32);
                    if (fq == 0) ss[(size_t)r * 8 + (pn & 1) * 4 + wc] = q; }
        } else if (pn < 12) {
            const bool isq = pn < 8; bf16_t* dst = isq ? QD : KD; const int colt = (pn - (isq ? 4 : 8)) * 256 + cl; const float sc = isq ? QS_DIF : 1.0f;
#pragma unroll
            for (int ai = 0; ai < 2; ++ai)
#pragma unroll
                for (int m = 0; m < 4; ++m) { const int r = EPI_ROWS(ai, m), pos = r & 4095;
#pragma unroll
                    for (int bj = 0; bj < 2; ++bj) { const int c = colt + bj * 128, i0 = (c & 63) >> 1;
                        const f32x4* rp = (const f32x4*)(ROPE + ((size_t)pos * 32 + i0) * 2);
                        const f32x4 v0 = rope4(acc[ai][bj][m][0], rp[0]) * sc, v1 = rope4(acc[ai][bj][m][1], rp[1]) * sc;
                        *(u32x4*)(dst + (size_t)r * 1024 + c) = pack8(v0, v1); } }
        } else if (pn < 28) {
            bf16_t* dst = pn < 20 ? GA : GB; const int colt = (pn - (pn < 20 ? 12 : 20)) * 256 + cl;
#pragma unroll
            for (int ai = 0; ai < 2; ++ai)
#pragma unroll
                for (int m = 0; m < 4; ++m) { const int r = EPI_ROWS(ai, m);
#pragma unroll
                    for (int bj = 0; bj < 2; ++bj) { f32x4 v0 = acc[ai][bj][m][0], v1 = acc[ai][bj][m][1];
#pragma unroll
                        for (int e = 0; e < 4; ++e) { v0[e] = sigmoidf_(v0[e]); v1[e] = sigmoidf_(v1[e]); }
                        *(u32x4*)(dst + (size_t)r * 2048 + colt + bj * 128) = pack8(v0, v1); } }
        } else {
            if (wc < 2) {
#pragma unroll
                for (int ai = 0; ai < 2; ++ai)
#pragma unroll
                    for (int m = 0; m < 4; ++m) { const int r = EPI_ROWS(ai, m), pos = r & 4095, i0 = cl >> 1;
                        const f32x4* rp = (const f32x4*)(ROPE + ((size_t)pos * 32 + i0) * 2);
                        const u32x4 w = pack8(rope4(acc[ai][0][m][0], rp[0]), rope4(acc[ai][0][m][1], rp[1]));
#pragma unroll
                        for (int h = 0; h < 8; ++h) *(u32x4*)(KM + ((size_t)r * 8 + h) * 192 + 128 + cl) = w; }
            }
        }
    }
};

__device__ __forceinline__ float rstd512(const float* ss, int row) { const f32x4* p = (const f32x4*)(ss + (size_t)row * 8); const f32x4 a = p[0], b = p[1];
    const float s = ((a[0] + a[1]) + (a[2] + a[3])) + ((b[0] + b[1]) + (b[2] + b[3])); return __builtin_amdgcn_rsqf(s * (1.0f / 512.0f) + 1e-6f); }

struct EpiP2 {
    static constexpr bool PERM = true;
    bf16_t *QM, *KM, *VMT; const float *SSQ, *SSKV; const float* ROPE;
    __device__ __forceinline__ void operator()(AccRef acc, const Unit& u, int wr, int wc, int fr, int fq) const {
        const int row0 = u.pm * 256 + wr * 64 + fr, cl = wc * 32 + 8 * fq;
        if (u.sel == 2) {
            const int t0 = u.pn * 256 + cl; float rs[2][8];
#pragma unroll
            for (int bj = 0; bj < 2; ++bj)
#pragma unroll
                for (int e = 0; e < 8; ++e) rs[bj][e] = rstd512(SSKV, t0 + bj * 128 + e);
#pragma unroll
            for (int ai = 0; ai < 2; ++ai)
#pragma unroll
                for (int m = 0; m < 4; ++m) { const int r = EPI_ROWS(ai, m);
#pragma unroll
                    for (int bj = 0; bj < 2; ++bj) { const int t = t0 + bj * 128, b = t >> 12, s = t & 4095; f32x4 v0 = acc[ai][bj][m][0], v1 = acc[ai][bj][m][1];
#pragma unroll
                        for (int e = 0; e < 4; ++e) { v0[e] *= rs[bj][e]; v1[e] *= rs[bj][4 + e]; }
                        *(u32x4*)(VMT + ((size_t)(b * 1024 + r) * 4096 + s)) = pack8(v0, v1); } }
            return;
        }
        const int pn = u.pn;
#pragma unroll
        for (int ai = 0; ai < 2; ++ai)
#pragma unroll
            for (int m = 0; m < 4; ++m) { const int r = EPI_ROWS(ai, m), pos = r & 4095;
                const float sc = u.sel == 0 ? rstd512(SSQ, r) * QS_MLA : rstd512(SSKV, r);
#pragma unroll
                for (int bj = 0; bj < 2; ++bj) { f32x4 v0 = acc[ai][bj][m][0], v1 = acc[ai][bj][m][1];
                    if (u.sel == 0 && pn >= 4) { const int c = (pn - 4) * 256 + cl + bj * 128, h = c >> 6, w = c & 63, i0 = w >> 1;
                        const f32x4* rp = (const f32x4*)(ROPE + ((size_t)pos * 32 + i0) * 2);
                        v0 = rope4(v0, rp[0]) * sc; v1 = rope4(v1, rp[1]) * sc;
                        *(u32x4*)(QM + ((size_t)r * 8 + h) * 192 + 128 + w) = pack8(v0, v1);
                    } else { const int c = pn * 256 + cl + bj * 128, h = c >> 7, w = c & 127; bf16_t* dst = u.sel == 0 ? QM : KM;
                        v0 = v0 * sc; v1 = v1 * sc;
                        *(u32x4*)(dst + ((size_t)r * 8 + h) * 192 + w) = pack8(v0, v1); } } }
    }
};

struct EpiP4 {
    static constexpr bool PERM = true;
    const bf16_t *GA, *GB; float* TMP; bf16_t* MIX;
    __device__ __forceinline__ void operator()(AccRef acc, const Unit& u, int wr, int wc, int fr, int fq) const {
        const int row0 = u.pm * 256 + wr * 64 + fr, col0 = u.pn * 256 + wc * 32 + 8 * fq;
#pragma unroll
        for (int ai = 0; ai < 2; ++ai)
#pragma unroll
            for (int m = 0; m < 4; ++m) { const int r = EPI_ROWS(ai, m);
#pragma unroll
                for (int bj = 0; bj < 2; ++bj) { const size_t off = (size_t)r * 2048 + col0 + bj * 128; f32x4 g0, g1;
                    unpack8(*(const u32x4*)((u.sel == 0 ? GA : GB) + off), g0, g1);
                    f32x4 v0 = acc[ai][bj][m][0] * g0, v1 = acc[ai][bj][m][1] * g1;
                    if (u.sel == 0) { *(f32x4*)(TMP + off) = v0; *(f32x4*)(TMP + off + 4) = v1; }
                    else { v0 += *(const f32x4*)(TMP + off); v1 += *(const f32x4*)(TMP + off + 4); *(u32x4*)(MIX + off) = pack8(v0, v1); } } }
    }
};
struct EpiRes {
    static constexpr bool PERM = true;
    const float* BASE; float* OUT;
    __device__ __forceinline__ void operator()(AccRef acc, const Unit& u, int wr, int wc, int fr, int fq) const {
        const int row0 = u.pm * 256 + wr * 64 + fr, col0 = u.pn * 256 + wc * 32 + 8 * fq;
#pragma unroll
        for (int ai = 0; ai < 2; ++ai)
#pragma unroll
            for (int m = 0; m < 4; ++m) { const int r = EPI_ROWS(ai, m);
#pragma unroll
                for (int bj = 0; bj < 2; ++bj) { const size_t off = (size_t)r * 2048 + col0 + bj * 128;
                    const f32x4 b0 = *(const f32x4*)(BASE + off), b1 = *(const f32x4*)(BASE + off + 4);
                    *(f32x4*)(OUT + off) = b0 * ALPHA + acc[ai][bj][m][0]; *(f32x4*)(OUT + off + 4) = b1 * ALPHA + acc[ai][bj][m][1]; } }
    }
};
struct EpiSwiGLU {
    static constexpr bool PERM = true;
    bf16_t* ACT;
    __device__ __forceinline__ void operator()(AccRef acc, const Unit& u, int wr, int wc, int fr, int fq) const {
        const int row0 = u.pm * 256 + wr * 64 + fr, col0 = u.pn * 128 + wc * 32 + 8 * fq;
#pragma unroll
        for (int ai = 0; ai < 2; ++ai)
#pragma unroll
            for (int m = 0; m < 4; ++m) { const int r = EPI_ROWS(ai, m); f32x4 v0, v1;
#pragma unroll
                for (int e = 0; e < 4; ++e) { const float g0 = acc[ai][0][m][0][e], g1 = acc[ai][0][m][1][e];
                    v0[e] = g0 * sigmoidf_(g0) * acc[ai][1][m][0][e]; v1[e] = g1 * sigmoidf_(g1) * acc[ai][1][m][1][e]; }
                *(u32x4*)(ACT + (size_t)r * DFF + col0) = pack8(v0, v1); }
    }
};

__device__ __forceinline__ unsigned f2bf(float f) { unsigned u = __builtin_bit_cast(unsigned, f); return (u + 0x7fffu + ((u >> 16) & 1u)) >> 16; }
__device__ __forceinline__ unsigned pk2(float lo, float hi) { return f2bf(lo) | (f2bf(hi) << 16); }
__device__ __forceinline__ int il64(int j) { return j < 32 ? 2 * j : 2 * (j - 32) + 1; }

__device__ __forceinline__ bf16_t* dst_row(unsigned char* ws, int mat, int c) {
    switch (mat) {
    case 0: {
        bf16_t* W = (bf16_t*)(ws + WS_WIN);
        if (c < 1024) return W + (size_t)c * 2048;
        if (c < 1088) return W + (size_t)(7168 + il64(c - 1024)) * 2048;
        if (c < 3136) { const int c2 = c - 1088; return W + (size_t)(1024 + (c2 & ~63) + il64(c2 & 63)) * 2048; }
        if (c < 4160) return (bf16_t*)(ws + WS_WDV) + (size_t)(c - 3136) * 2048;
        return W + (size_t)(3072 + (c - 4160)) * 2048; }
    case 1: {
        const int h = c / 192, w = c % 192; bf16_t* W = (bf16_t*)(ws + WS_WUQ);
        return w < 128 ? W + (size_t)(h * 128 + w) * 512 : W + (size_t)(1024 + h * 64 + il64(w - 128)) * 512; }
    case 2: {
        const int h = c >> 8, w = c & 255;
        return w < 128 ? (bf16_t*)(ws + WS_WUK) + (size_t)(h * 128 + w) * 512 : (bf16_t*)(ws + WS_WUV) + (size_t)(h * 128 + (w - 128)) * 512; }
    case 3: return (bf16_t*)(ws + WS_WBA) + (size_t)c * 1024;
    case 4: return (bf16_t*)(ws + WS_WBB) + (size_t)c * 1024;
    case 5: return (bf16_t*)(ws + WS_WOUT) + (size_t)c * 2048;
    case 6: {
        const int up = c >= DFF, cc = up ? c - DFF : c; return (bf16_t*)(ws + WS_WFI) + (size_t)((cc >> 7) * 256 + up * 128 + (cc & 127)) * 2048; }
    default: return (bf16_t*)(ws + WS_WFD) + (size_t)c * DFF;
    }
}
__device__ __forceinline__ void transpose_item(const float* W, int N, const float* gain, unsigned char* ws, int mat, LAS float* scr, int item, int lane) {
    const int nblk = N / 32, kb = item / nblk, nb = item % nblk, k0 = 64 * kb, n0 = 32 * nb;
    float tv[32];
    { const float* wp = W + (size_t)(k0 + (lane >> 5)) * N + n0 + (lane & 31);
#pragma unroll
      for (int i = 0; i < 32; ++i) tv[i] = wp[(size_t)(2 * i) * N];
      if (gain) {
#pragma unroll
          for (int i = 0; i < 32; ++i) tv[i] *= gain[k0 + 2 * i + (lane >> 5)]; }
#pragma unroll
      for (int i = 0; i < 32; ++i) scr[(2 * i + (lane >> 5)) * 33 + (lane & 31)] = tv[i]; }
    asm volatile("s_waitcnt lgkmcnt(0)" ::: "memory");
    const int c = lane & 7;
#pragma unroll
    for (int j = 0; j < 4; ++j) { const int n = (lane >> 3) + 8 * j; const LAS float* s = scr + (8 * c) * 33 + n;
        u32x4 o; o.x = pk2(s[0 * 33], s[1 * 33]); o.y = pk2(s[2 * 33], s[3 * 33]); o.z = pk2(s[4 * 33], s[5 * 33]); o.w = pk2(s[6 * 33], s[7 * 33]);
        *(u32x4*)(dst_row(ws, mat, n0 + n) + k0 + 8 * c) = o; }
    asm volatile("s_waitcnt lgkmcnt(0)" ::: "memory");
}
__device__ __forceinline__ void prologue(const Params& p, LAS unsigned char* lds, int tid, int wid, int lane) {
    LAS float* scr = (LAS float*)(lds + wid * 8704);
    const int gw = blockIdx.x * NWAVES + wid, NGW = gridDim.x * NWAVES;
    constexpr int I0 = 32 * 258, I1 = 8 * 48, I2 = 8 * 64, I3 = 16 * 64, I4 = 16 * 64, I5 = 32 * 64, I6 = 32 * 352, I7 = 88 * 64;
    constexpr int NITEMS = I0 + I1 + I2 + I3 + I4 + I5 + I6 + I7;
    for (int it = gw; it < NITEMS; it += NGW) {
        int r = it;
        if (r < I6) { transpose_item(p.w_fi, 2 * DFF, nullptr, p.ws, 6, scr, r, lane); continue; } r -= I6;
        if (r < I0) { transpose_item(p.w_in, INW, nullptr, p.ws, 0, scr, r, lane); continue; } r -= I0;
        if (r < I7) { transpose_item(p.w_fd, DM, nullptr, p.ws, 7, scr, r, lane); continue; } r -= I7;
        if (r < I5) { transpose_item(p.w_out, DM, nullptr, p.ws, 5, scr, r, lane); continue; } r -= I5;
        if (r < I3) { transpose_item(p.w_ba, DM, nullptr, p.ws, 3, scr, r, lane); continue; } r -= I3;
        if (r < I4) { transpose_item(p.w_bb, DM, nullptr, p.ws, 4, scr, r, lane); continue; } r -= I4;
        if (r < I1) { transpose_item(p.w_uq, 1536, p.qn, p.ws, 1, scr, r, lane); continue; } r -= I1;
        transpose_item(p.w_ukv, 2048, p.kvn, p.ws, 2, scr, r, lane);
    }
    const int gt = blockIdx.x * NTHR + tid, NGT = gridDim.x * NTHR;
    { const f32x4* xs = (const f32x4*)p.x; u32x4* xd = (u32x4*)(p.ws + WS_XB);
      for (int i0 = gt; i0 < T * DM / 8; i0 += 4 * NGT) { f32x4 a[4], b[4];
#pragma unroll
          for (int u = 0; u < 4; ++u) { const int i = i0 + u * NGT; a[u] = xs[2 * i]; b[u] = xs[2 * i + 1]; }
#pragma unroll
          for (int u = 0; u < 4; ++u) { const int i = i0 + u * NGT; xd[i] = pack8(a[u], b[u]); } } }
    { float* rt = (float*)(p.ws + WS_ROPE);
      for (int i = gt; i < SEQ * 32; i += NGT) { const int pos = i >> 5, k = i & 31; const float ang = (float)pos * p.inv_freq[k];
          double rev = (double)ang * 0.15915494309189535; rev -= floor(rev); const float rv = (float)rev;
          rt[2 * i] = __builtin_amdgcn_cosf(rv); rt[2 * i + 1] = __builtin_amdgcn_sinf(rv); } }
}

__device__ __forceinline__ float wave_sum(float v) {
#pragma unroll
    for (int o = 1; o < 64; o <<= 1) v += __shfl_xor(v, o);
    return v;
}
template <bool BF> __device__ __forceinline__ void ln_rows(const float* in, const float* g, const float* b, float* outf, bf16_t* outb, int wid, int lane) {
    const int gw = blockIdx.x * NWAVES + wid, NGW = gridDim.x * NWAVES;
    for (int row = gw; row < T; row += NGW) {
        const f32x4* xr = (const f32x4*)(in + (size_t)row * DM) + 2 * lane;
        f32x4 v[8]; float s = 0.f;
#pragma unroll
        for (int j = 0; j < 4; ++j) { v[2 * j] = xr[128 * j]; v[2 * j + 1] = xr[128 * j + 1]; }
#pragma unroll
        for (int j = 0; j < 8; ++j) s += (v[j][0] + v[j][1]) + (v[j][2] + v[j][3]);
        const float mean = wave_sum(s) * (1.f / DM); float s2 = 0.f;
#pragma unroll
        for (int j = 0; j < 8; ++j) { v[j] = v[j] - mean; s2 += (v[j][0] * v[j][0] + v[j][1] * v[j][1]) + (v[j][2] * v[j][2] + v[j][3] * v[j][3]); }
        const float rstd = 1.0f / sqrtf(wave_sum(s2) * (1.f / DM) + 1e-5f);
#pragma unroll
        for (int j = 0; j < 4; ++j) { const int c = 512 * j + 8 * lane;
            const f32x4 g0 = *(const f32x4*)(g + c), g1 = *(const f32x4*)(g + c + 4), b0 = *(const f32x4*)(b + c), b1 = *(const f32x4*)(b + c + 4);
            const f32x4 y0 = v[2 * j] * rstd * g0 + b0, y1 = v[2 * j + 1] * rstd * g1 + b1;
            *(f32x4*)(outf + (size_t)row * DM + c) = y0; *(f32x4*)(outf + (size_t)row * DM + c + 4) = y1;
            if (BF) *(u32x4*)(outb + (size_t)row * DM + c) = pack8(y0, y1); }
    }
}

template <int DQK>
__device__ __forceinline__ void attn_pass(const bf16_t* __restrict__ Qg, int qstride, const bf16_t* __restrict__ Kg, int kstride, const bf16_t* __restrict__ Vt,
                                          int q0, LAS unsigned char* lds, f32x16 (&o)[4], int tid_in, int wid, int lane_in) {
    int tid = tid_in; asm volatile("" : "+v"(tid)); const int lane = tid & 63; (void)lane_in;
    constexpr int KROWB = DQK * 2 + 16, VROWB = 144, KBUF = 64 * KROWB, VBUF = 128 * VROWB, STAGE = KBUF + VBUF;
    constexpr int KCH = DQK / 8, NKL = (64 * KCH) / NTHR, ND = DQK / 16;
    static_assert(2 * STAGE <= LDS_BYTES && (64 * KCH) % NTHR == 0, "attention LDS");
    const int r32 = lane & 31, hi = lane >> 5;
    const int NT = (q0 + 256) >> 6;
    bf16x8 qf[ND];
    { const bf16_t* qrow = Qg + (size_t)(q0 + 32 * wid + r32) * qstride + 8 * hi;
#pragma unroll
      for (int dd = 0; dd < ND; ++dd) qf[dd] = *(const bf16x8*)(qrow + 16 * dd); }
    u32x4 kreg[NKL], vreg[2];
    unsigned kog[NKL], kol[NKL], vog[2], vol[2];
#pragma unroll
    for (int i = 0; i < NKL; ++i) { const int ch = tid + NTHR * i, kr = ch / KCH, kc = ch % KCH; kog[i] = (unsigned)(kr * kstride + kc * 8) * 2u; kol[i] = (unsigned)(kr * KROWB + kc * 16); }
#pragma unroll
    for (int i = 0; i < 2; ++i) { const int ch = tid + NTHR * i; vog[i] = (unsigned)((ch >> 3) * 4096 + (ch & 7) * 8) * 2u; vol[i] = (unsigned)(KBUF + (ch >> 3) * VROWB + (ch & 7) * 16); }
#define ATT_LOAD(j) do { const char* kb_ = (const char*)Kg + (size_t)(64 * (j)) * kstride * 2; const char* vb_ = (const char*)Vt + (size_t)(64 * (j)) * 2; \
        _Pragma("unroll") for (int i = 0; i < NKL; ++i) kreg[i] = *(const u32x4*)(kb_ + kog[i]); \
        _Pragma("unroll") for (int i = 0; i < 2; ++i) vreg[i] = *(const u32x4*)(vb_ + vog[i]); } while (0)
#define ATT_STORE(buf) do { LAS unsigned char* base_ = lds + (buf) * STAGE; \
        _Pragma("unroll") for (int i = 0; i < NKL; ++i) *(LAS u32x4*)(base_ + kol[i]) = kreg[i]; \
        _Pragma("unroll") for (int i = 0; i < 2; ++i) *(LAS u32x4*)(base_ + vol[i]) = vreg[i]; } while (0)
    float mrun = -INFINITY, lrun = 0.f;
#pragma unroll
    for (int d0 = 0; d0 < 4; ++d0)
#pragma unroll
        for (int r = 0; r < 16; ++r) o[d0][r] = 0.f;
    const int prow = ((r32 & ~12) | ((r32 & 4) << 1) | ((r32 & 8) >> 1));
    const int koff = prow * KROWB + 16 * hi, voff = KBUF + r32 * VROWB + 16 * hi;
    const int qg = q0 + 32 * wid + r32, qmaxw = q0 + 32 * wid + 31;
    ATT_LOAD(0); ATT_STORE(0); __syncthreads();
    for (int j = 0; j < NT; ++j) {
        if (j + 1 < NT) ATT_LOAD(j + 1);
        if (64 * j <= qmaxw) {
            LAS unsigned char* base = lds + (j & 1) * STAGE;
            f32x16 s0, s1;
#pragma unroll
            for (int r = 0; r < 16; ++r) { s0[r] = 0.f; s1[r] = 0.f; }
#pragma unroll
            for (int dd = 0; dd < ND; ++dd) {
                const bf16x8 k0 = *(const LAS bf16x8*)(base + koff + 32 * dd), k1 = *(const LAS bf16x8*)(base + koff + 32 * KROWB + 32 * dd);
                s0 = __builtin_amdgcn_mfma_f32_32x32x16_bf16(k0, qf[dd], s0, 0, 0, 0);
                s1 = __builtin_amdgcn_mfma_f32_32x32x16_bf16(k1, qf[dd], s1, 0, 0, 0);
                if ((dd & 3) == 3) __builtin_amdgcn_sched_barrier(0);
            }
            if (j >= NT - 4) { const int kb = 64 * j + 8 * hi;
#pragma unroll
                for (int r = 0; r < 16; ++r) { const int kv = kb + 16 * (r >> 3) + (r & 7); if (kv > qg) s0[r] = -INFINITY; if (kv + 32 > qg) s1[r] = -INFINITY; } }
            float mx = fmaxf(s0[0], s1[0]);
#pragma unroll
            for (int r = 1; r < 16; ++r) mx = fmaxf(mx, fmaxf(s0[r], s1[r]));
            mx = fmaxf(mx, __shfl_xor(mx, 32));
            const float mnew = fmaxf(mrun, mx), al = __builtin_amdgcn_exp2f(mrun - mnew); mrun = mnew;
            float ps = 0.f;
#pragma unroll
            for (int r = 0; r < 16; ++r) { s0[r] = __builtin_amdgcn_exp2f(s0[r] - mnew); s1[r] = __builtin_amdgcn_exp2f(s1[r] - mnew); ps += s0[r] + s1[r]; }
            lrun = lrun * al + ps;
#pragma unroll
            for (int d0 = 0; d0 < 4; ++d0)
#pragma unroll
                for (int r = 0; r < 16; ++r) o[d0][r] *= al;
            bf16x8 pk[4];
            { u32x4 w;
              w.x = cvt_pk_bf16(s0[0], s0[1]); w.y = cvt_pk_bf16(s0[2], s0[3]); w.z = cvt_pk_bf16(s0[4], s0[5]); w.w = cvt_pk_bf16(s0[6], s0[7]); pk[0] = __builtin_bit_cast(bf16x8, w);
              w.x = cvt_pk_bf16(s0[8], s0[9]); w.y = cvt_pk_bf16(s0[10], s0[11]); w.z = cvt_pk_bf16(s0[12], s0[13]); w.w = cvt_pk_bf16(s0[14], s0[15]); pk[1] = __builtin_bit_cast(bf16x8, w);
              w.x = cvt_pk_bf16(s1[0], s1[1]); w.y = cvt_pk_bf16(s1[2], s1[3]); w.z = cvt_pk_bf16(s1[4], s1[5]); w.w = cvt_pk_bf16(s1[6], s1[7]); pk[2] = __builtin_bit_cast(bf16x8, w);
              w.x = cvt_pk_bf16(s1[8], s1[9]); w.y = cvt_pk_bf16(s1[10], s1[11]); w.z = cvt_pk_bf16(s1[12], s1[13]); w.w = cvt_pk_bf16(s1[14], s1[15]); pk[3] = __builtin_bit_cast(bf16x8, w); }
#pragma unroll
            for (int sp = 0; sp < 4; ++sp)
#pragma unroll
                for (int d0 = 0; d0 < 4; ++d0) {
                    const bf16x8 vf = *(const LAS bf16x8*)(base + voff + d0 * 32 * VROWB + 32 * sp);
                    o[d0] = __builtin_amdgcn_mfma_f32_32x32x16_bf16(vf, pk[sp], o[d0], 0, 0, 0);
                    if (d0 == 3) __builtin_amdgcn_sched_barrier(0);
                }
        }
        if (j + 1 < NT) ATT_STORE((j + 1) & 1);
        __syncthreads();
    }
    lrun += __shfl_xor(lrun, 32);
    const float rl = 1.0f / lrun;
#pragma unroll
    for (int d0 = 0; d0 < 4; ++d0)
#pragma unroll
        for (int r = 0; r < 16; ++r) o[d0][r] *= rl;
#undef ATT_LOAD
#undef ATT_STORE
}
__device__ __forceinline__ void attn_store(const f32x16 (&o)[4], bf16_t* orow, int hi) {
#pragma unroll
    for (int d0 = 0; d0 < 4; ++d0)
#pragma unroll
        for (int g = 0; g < 4; ++g) { u32x2 w; w.x = cvt_pk_bf16(o[d0][4 * g], o[d0][4 * g + 1]); w.y = cvt_pk_bf16(o[d0][4 * g + 2], o[d0][4 * g + 3]);
            *(u32x2*)(orow + 32 * d0 + 8 * g + 4 * hi) = w; }
}
__device__ __forceinline__ void attention_phase(const Params& p, LAS unsigned char* lds, int tid, int wid, int lane) {
    const bf16_t* QM = (const bf16_t*)(p.ws + WS_QM); const bf16_t* KM = (const bf16_t*)(p.ws + WS_KM); const bf16_t* VMT = (const bf16_t*)(p.ws + WS_VMT);
    const bf16_t* QD = (const bf16_t*)(p.ws + WS_QD); const bf16_t* KD = (const bf16_t*)(p.ws + WS_KD); const bf16_t* VDT = (const bf16_t*)(p.ws + WS_VDT);
    bf16_t* MLAO = (bf16_t*)(p.ws + WS_MLAO); bf16_t* DIFO = (bf16_t*)(p.ws + WS_DIFO);
    const int r32 = lane & 31, hi = lane >> 5;
    for (int u = blockIdx.x; u < 256; u += gridDim.x) {
        const int bh = u >> 4, b = bh >> 3, h = bh & 7, qbm = u & 15, qbd = 15 - qbm;
        f32x16 o[4];
#ifndef ATTMASK
#define ATTMASK 3
#endif
        if (ATTMASK & 1) {
            const int q0 = qbm * 256;
            attn_pass<192>(QM + (size_t)b * SEQ * 1536 + h * 192, 1536, KM + (size_t)b * SEQ * 1536 + h * 192, 1536, VMT + (size_t)(b * 1024 + h * 128) * 4096, q0, lds, o, tid, wid, lane);
            attn_store(o, MLAO + (size_t)(b * SEQ + q0 + 32 * wid + r32) * 1024 + h * 128, hi);
        }
        if (ATTMASK & 2) {
            const int q0 = qbd * 256; unsigned o1p[4][8];
            attn_pass<64>(QD + (size_t)b * SEQ * 1024 + h * 128, 1024, KD + (size_t)b * SEQ * 1024 + h * 128, 1024, VDT + (size_t)(b * 1024 + h * 128) * 4096, q0, lds, o, tid, wid, lane);
#pragma unroll
            for (int d0 = 0; d0 < 4; ++d0)
#pragma unroll
                for (int r = 0; r < 8; ++r) o1p[d0][r] = cvt_pk_bf16(o[d0][2 * r], o[d0][2 * r + 1]);
            attn_pass<64>(QD + (size_t)b * SEQ * 1024 + h * 128 + 64, 1024, KD + (size_t)b * SEQ * 1024 + h * 128 + 64, 1024, VDT + (size_t)(b * 1024 + h * 128) * 4096, q0, lds, o, tid, wid, lane);
            const float lam = expf(wave_sum(p.lq1[lane] * p.lk1[lane])) - expf(wave_sum(p.lq2[lane] * p.lk2[lane])) + 0.2f;
            float ss = 0.f;
#pragma unroll
            for (int d0 = 0; d0 < 4; ++d0)
#pragma unroll
                for (int r = 0; r < 16; ++r) { const unsigned w = o1p[d0][r >> 1]; const float a1 = (r & 1) ? __uint_as_float(w & 0xffff0000u) : __uint_as_float(w << 16); const float v = a1 - lam * o[d0][r]; o[d0][r] = v; ss += v * v; }
            ss += __shfl_xor(ss, 32);
            const float rs = __builtin_amdgcn_rsqf(ss * (1.0f / 128.0f) + 1e-5f) * 0.8f;
#pragma unroll
            for (int d0 = 0; d0 < 4; ++d0)
#pragma unroll
                for (int g = 0; g < 4; ++g) { const f32x4 gv = *(const f32x4*)(p.subln + 32 * d0 + 8 * g + 4 * hi);
#pragma unroll
                    for (int e = 0; e < 4; ++e) o[d0][4 * g + e] *= rs * gv[e]; }
            attn_store(o, DIFO + (size_t)(b * SEQ + q0 + 32 * wid + r32) * 1024 + h * 128, hi);
        }
    }
}


__device__ __forceinline__ float bf2f(bf16_t v) { return __uint_as_float(((unsigned)v) << 16); }
#ifndef STOPAT
#define STOPAT 99
#endif
#define DUMP_BEGIN() const size_t NTOT_ = (size_t)T * DM; for (size_t i_ = (size_t)blockIdx.x * NTHR + threadIdx.x; i_ < NTOT_; i_ += (size_t)gridDim.x * NTHR) { float acc_ = 0.f;
#define DUMP_BF(off, n) acc_ += bf2f(((const bf16_t*)(ws + (off)))[i_ % (size_t)(n)]);
#define DUMP_F32(off, n) acc_ += ((const float*)(ws + (off)))[i_ % (size_t)(n)];
#define DUMP_END() p.out[i_] = acc_; } return;

__device__ __forceinline__ void krope_phase(const Params& p, LAS unsigned char* lds, int tid, int wid, int lane) {
    const bf16_t* XB = (const bf16_t*)(p.ws + WS_XB); const bf16_t* WK = (const bf16_t*)(p.ws + WS_WIN) + (size_t)7168 * 2048;
    bf16_t* KM = (bf16_t*)(p.ws + WS_KM); const float* ROPE = (const float*)(p.ws + WS_ROPE);
    const int r32 = lane & 31, hi = lane >> 5;
    LAS float* red = (LAS float*)lds;
    for (int blk = blockIdx.x; blk < T / 32; blk += gridDim.x) {
        const bf16_t* ap = XB + (size_t)(blk * 32 + r32) * 2048 + wid * 256 + 8 * hi;
        const bf16_t* bp = WK + (size_t)r32 * 2048 + wid * 256 + 8 * hi;
        f32x16 c0, c1;
#pragma unroll
        for (int r = 0; r < 16; ++r) { c0[r] = 0.f; c1[r] = 0.f; }
#pragma unroll 4
        for (int dd = 0; dd < 16; ++dd) {
            const bf16x8 a = *(const bf16x8*)(ap + 16 * dd), b0 = *(const bf16x8*)(bp + 16 * dd), b1 = *(const bf16x8*)(bp + (size_t)32 * 2048 + 16 * dd);
            c0 = __builtin_amdgcn_mfma_f32_32x32x16_bf16(a, b0, c0, 0, 0, 0);
            c1 = __builtin_amdgcn_mfma_f32_32x32x16_bf16(a, b1, c1, 0, 0, 0);
        }
#pragma unroll
        for (int r = 0; r < 16; ++r) { const int row = (r & 3) + 8 * (r >> 2) + 4 * hi;
            red[(wid * 32 + row) * 64 + r32] = c0[r]; red[(wid * 32 + row) * 64 + 32 + r32] = c1[r]; }
        __syncthreads();
        { const int row = tid >> 4, c4 = (tid & 15) * 4; f32x4 v = {0.f, 0.f, 0.f, 0.f};
#pragma unroll
          for (int w = 0; w < 8; ++w) v += *(const LAS f32x4*)(red + (w * 32 + row) * 64 + c4);
          const int t = blk * 32 + row, pos = t & 4095;
          const f32x4 cs = *(const f32x4*)(ROPE + ((size_t)pos * 32 + (c4 >> 1)) * 2);
          const f32x4 o = rope4(v, cs); u32x2 w2; w2.x = cvt_pk_bf16(o[0], o[1]); w2.y = cvt_pk_bf16(o[2], o[3]);
#pragma unroll
          for (int h = 0; h < 8; ++h) *(u32x2*)(KM + ((size_t)t * 8 + h) * 192 + 128 + c4) = w2; }
        __syncthreads();
    }
}
#define XB_TMO      128
#define XB_XCNT(j)  (256  + 64 * (j))
#define XB_XSUB(j)  (1280 + 64 * (j))
#define XB_XGEN(j)  (2304 + 64 * (j))
#define XB_TOP      3328
#define XB_TOPGEN   3392
#define XCD_BAR_WORDS 3456
#define XB_SPIN_CAP (1u << 18)

__device__ __forceinline__ unsigned xb_ld(unsigned* p)              { return __hip_atomic_load(p, __ATOMIC_RELAXED, __HIP_MEMORY_SCOPE_AGENT); }
__device__ __forceinline__ unsigned xb_add(unsigned* p, unsigned v) { return __hip_atomic_fetch_add(p, v, __ATOMIC_RELAXED, __HIP_MEMORY_SCOPE_AGENT); }
__device__ __forceinline__ unsigned xb_xcc_id() { return (unsigned)__builtin_amdgcn_s_getreg((3 << 11) | 20) & 0xFu; }
#define XB_SPIN(cond, bar) do { unsigned _sp = 0; while (cond) { __builtin_amdgcn_s_sleep(1); \
    if ((++_sp & 255u) == 0u) { if (xb_ld(&(bar)[XB_TMO])) break; if (_sp > XB_SPIN_CAP) { atomicAdd(&(bar)[XB_TMO], 1u); break; } } } } while (0)

struct XcdBarrier {
    unsigned* bar; unsigned x;
    volatile LAS unsigned* st;
};

__device__ __forceinline__ XcdBarrier xcd_barrier_post(unsigned* bar, volatile LAS unsigned* st) {
    XcdBarrier b; b.bar = bar; b.x = xb_xcc_id(); b.st = st;
    if (threadIdx.x == 0) (void)xb_add(&bar[XB_XCNT(b.x)], 1u);
    return b;
}
__device__ __forceinline__ void xcd_barrier_complete(unsigned* bar, unsigned x, unsigned& nloc, unsigned& nx) {
    const unsigned G = gridDim.x * gridDim.y * gridDim.z;
    unsigned sum, cnt, mine, sp = 0u;
    for (;;) {
        sum = 0u; cnt = 0u; mine = 0u;
#pragma unroll
        for (unsigned j = 0; j < 16; ++j) { const unsigned c = xb_ld(&bar[XB_XCNT(j)]); sum += c; cnt += (c > 0u) ? 1u : 0u; mine = (j == x) ? c : mine; }
        if (sum == G) break;
        __builtin_amdgcn_s_sleep(1);
        if ((++sp & 255u) == 0u) { if (xb_ld(&bar[XB_TMO])) break; if (sp > XB_SPIN_CAP) { atomicAdd(&bar[XB_TMO], 1u); break; } }
    }
    nloc = mine > 0u ? mine : 1u; nx = cnt > 0u ? cnt : 1u;
}

__device__ __forceinline__ void xcd_barrier(const XcdBarrier& b) {
    asm volatile("s_waitcnt vmcnt(0)" ::: "memory");
    __syncthreads();
    if (threadIdx.x == 0) {
        unsigned* bar = b.bar;
        __builtin_amdgcn_s_waitcnt(0);
        unsigned nloc = b.st[0], nx = b.st[1];
        if (nloc == 0u) { xcd_barrier_complete(bar, b.x, nloc, nx); b.st[0] = nloc; b.st[1] = nx; }
        const unsigned old = xb_add(&bar[XB_XSUB(b.x)], 1u);
        const unsigned gen = old / nloc;
        if (old + 1u == (gen + 1u) * nloc) {
            __builtin_amdgcn_fence(__ATOMIC_RELEASE, "agent");
            asm volatile("s_waitcnt vmcnt(0)" ::: "memory");
            const unsigned og = xb_add(&bar[XB_TOP], 1u);
            const unsigned tg = og / nx;
            if (og + 1u == (tg + 1u) * nx) xb_add(&bar[XB_TOPGEN], 1u);
            else XB_SPIN(xb_ld(&bar[XB_TOPGEN]) == tg, bar);
            __builtin_amdgcn_fence(__ATOMIC_ACQUIRE, "agent");
            xb_add(&bar[XB_XGEN(b.x)], 1u);
            asm volatile("s_waitcnt vmcnt(0)" ::: "memory");
        } else {
            XB_SPIN(xb_ld(&bar[XB_XGEN(b.x)]) == gen, bar);
            __builtin_amdgcn_fence(__ATOMIC_ACQUIRE, "agent");
            asm volatile("s_waitcnt vmcnt(0)" ::: "memory");
        }
    }
    __syncthreads();
}

__global__ void __launch_bounds__(NTHR, 2) fwd_megakernel(Params p) {
    extern __shared__ __attribute__((aligned(16))) unsigned char lds_raw[];
    LAS unsigned char* lds = (LAS unsigned char*)lds_raw;
    cg::grid_group grid = cg::this_grid();
    volatile LAS unsigned* bst = (volatile LAS unsigned*)(lds + 131072);
    if (threadIdx.x == 0) { bst[0] = 0u; bst[1] = 0u; }
    __syncthreads();
    XcdBarrier bar = xcd_barrier_post((unsigned*)p.ws, bst);
#define GRID_SYNC() xcd_barrier(bar)
    if (p.ph_hi - p.ph_lo > 1) grid.sync();
#define IN(k) (p.ph_lo <= (k) && (k) < p.ph_hi)
    const int tid = threadIdx.x, lane = tid & 63, wid = __builtin_amdgcn_readfirstlane(tid >> 6);
    const int G = gridDim.x, c = blockIdx.x;
    unsigned char* ws = p.ws;
    bf16_t* XB = (bf16_t*)(ws + WS_XB);
    const float* ROPE = (const float*)(ws + WS_ROPE);

    if IN(0) prologue(p, lds, tid, wid, lane);
    if (IN(0) && IN(1)) GRID_SYNC();
    if IN(1) {
        pg8::SegOrder S; S.A0 = XB; S.B0 = (const bf16_t*)(ws + WS_WIN); S.nM0 = 32; S.nN0 = 28;
        S.A1 = (const bf16_t*)(ws + WS_WDV); S.B1 = XB; S.nM1 = 4; S.nN1 = 32; S.A2 = nullptr; S.B2 = nullptr; S.nM2 = 0; S.nN2 = 0; S.init(2048, G, c);
        EpiP1 E{(bf16_t*)(ws + WS_CQ), (bf16_t*)(ws + WS_CKV), (bf16_t*)(ws + WS_QD), (bf16_t*)(ws + WS_KD), (bf16_t*)(ws + WS_VDT), (bf16_t*)(ws + WS_GA), (bf16_t*)(ws + WS_GB),
                (bf16_t*)(ws + WS_KM), (float*)(ws + WS_SSQ), (float*)(ws + WS_SSKV), ROPE};
        pg8::gemm_phase(lds, S, E);
    }
    if (IN(1) && IN(2)) GRID_SYNC();
    if IN(2) {
        krope_phase(p, lds, tid, wid, lane);
        pg8::SegOrder S; S.A0 = (const bf16_t*)(ws + WS_CQ); S.B0 = (const bf16_t*)(ws + WS_WUQ); S.nM0 = 32; S.nN0 = 6;
        S.A1 = (const bf16_t*)(ws + WS_CKV); S.B1 = (const bf16_t*)(ws + WS_WUK); S.nM1 = 32; S.nN1 = 4;
        S.A2 = (const bf16_t*)(ws + WS_WUV); S.B2 = (const bf16_t*)(ws + WS_CKV); S.nM2 = 4; S.nN2 = 32; S.init(512, G, c);
        EpiP2 E{(bf16_t*)(ws + WS_QM), (bf16_t*)(ws + WS_KM), (bf16_t*)(ws + WS_VMT), (const float*)(ws + WS_SSQ), (const float*)(ws + WS_SSKV), ROPE};
        pg8::gemm_phase(lds, S, E);
    }
    if (IN(2) && IN(3)) GRID_SYNC();
    if IN(3) attention_phase(p, lds, tid, wid, lane);
    if (IN(3) && IN(4)) GRID_SYNC();
    if IN(4) {
        pg8::PairOrder S; S.A0 = (const bf16_t*)(ws + WS_MLAO); S.B0 = (const bf16_t*)(ws + WS_WBA); S.A1 = (const bf16_t*)(ws + WS_DIFO); S.B1 = (const bf16_t*)(ws + WS_WBB);
        S.nM = 32; S.nN = 8; S.init(1024, G, c);
        EpiP4 E{(const bf16_t*)(ws + WS_GA), (const bf16_t*)(ws + WS_GB), (float*)(ws + WS_TMP), (bf16_t*)(ws + WS_MIX)};
        pg8::gemm_phase(lds, S, E);
    }
    if (IN(4) && IN(5)) GRID_SYNC();
    if IN(5) {
        pg8::SegOrder S; S.A0 = (const bf16_t*)(ws + WS_MIX); S.B0 = (const bf16_t*)(ws + WS_WOUT); S.nM0 = 32; S.nN0 = 8;
        S.A1 = S.B1 = S.A2 = S.B2 = nullptr; S.nM1 = S.nN1 = S.nM2 = S.nN2 = 0; S.init(2048, G, c);
        EpiRes E{p.x, (float*)(ws + WS_PRE)};
        pg8::gemm_phase(lds, S, E);
    }
    if (IN(5) && IN(6)) GRID_SYNC();
    if IN(6) ln_rows<true>((const float*)(ws + WS_PRE), p.ln1g, p.ln1b, (float*)(ws + WS_H1), (bf16_t*)(ws + WS_H1B), wid, lane);
    if (IN(6) && IN(7)) GRID_SYNC();
    if IN(7) {
        pg8::SegOrder S; S.A0 = (const bf16_t*)(ws + WS_H1B); S.B0 = (const bf16_t*)(ws + WS_WFI); S.nM0 = 32; S.nN0 = 44;
        S.A1 = S.B1 = S.A2 = S.B2 = nullptr; S.nM1 = S.nN1 = S.nM2 = S.nN2 = 0; S.init(2048, G, c);
        EpiSwiGLU E{(bf16_t*)(ws + WS_ACT)};
        pg8::gemm_phase(lds, S, E);
    }
    if (IN(7) && IN(8)) GRID_SYNC();
    if IN(8) {
        pg8::SegOrder S; S.A0 = (const bf16_t*)(ws + WS_ACT); S.B0 = (const bf16_t*)(ws + WS_WFD); S.nM0 = 32; S.nN0 = 8;
        S.A1 = S.B1 = S.A2 = S.B2 = nullptr; S.nM1 = S.nN1 = S.nM2 = S.nN2 = 0; S.init(DFF, G, c);
        EpiRes E{(const float*)(ws + WS_H1), (float*)(ws + WS_H1)};
        pg8::gemm_phase(lds, S, E);
    }
    if (IN(8) && IN(9)) GRID_SYNC();
    if IN(9) ln_rows<false>((const float*)(ws + WS_H1), p.ln2g, p.ln2b, p.out, nullptr, wid, lane);
}

extern "C" void kernel_launch(void* const* d_in, const int* in_sizes, int n_in, void* d_out, int out_size, void* d_ws, size_t ws_size, hipStream_t stream) {
    static int grid_blocks = 0;
    if (grid_blocks == 0) {
        if (n_in != 20 || in_sizes[0] != T * DM || out_size != T * DM || ws_size < WS_END) { fprintf(stderr, "kernel_launch: unexpected shapes (n_in %d, in0 %d, out %d, ws %zu)\n", n_in, n_in > 0 ? in_sizes[0] : -1, out_size, ws_size); grid_blocks = -1; return; }
        int dev = 0, cus = 0, per_cu = 0;
        (void)hipGetDevice(&dev);
        (void)hipDeviceGetAttribute(&cus, hipDeviceAttributeMultiprocessorCount, dev);
        if (hipFuncSetAttribute((const void*)fwd_megakernel, hipFuncAttributeMaxDynamicSharedMemorySize, LDS_BYTES) != hipSuccess) { fprintf(stderr, "kernel_launch: hipFuncSetAttribute failed\n"); grid_blocks = -1; return; }
        if (hipOccupancyMaxActiveBlocksPerMultiprocessor(&per_cu, (const void*)fwd_megakernel, NTHR, LDS_BYTES) != hipSuccess || per_cu < 1) { fprintf(stderr, "kernel_launch: occupancy query failed (%d)\n", per_cu); (void)hipGetLastError(); per_cu = 1; }
        grid_blocks = cus * (per_cu > 1 ? 1 : per_cu);
        if (grid_blocks > 256) grid_blocks = 256;
    }
    if (grid_blocks < 0) return;
    Params p{};
    p.x = (const float*)d_in[0]; p.w_in = (const float*)d_in[1]; p.qn = (const float*)d_in[2]; p.w_uq = (const float*)d_in[3]; p.kvn = (const float*)d_in[4]; p.w_ukv = (const float*)d_in[5];
    p.lq1 = (const float*)d_in[6]; p.lk1 = (const float*)d_in[7]; p.lq2 = (const float*)d_in[8]; p.lk2 = (const float*)d_in[9]; p.subln = (const float*)d_in[10];
    p.w_ba = (const float*)d_in[11]; p.w_bb = (const float*)d_in[12]; p.w_out = (const float*)d_in[13]; p.ln1g = (const float*)d_in[14]; p.ln1b = (const float*)d_in[15];
    p.w_fi = (const float*)d_in[16]; p.w_fd = (const float*)d_in[17]; p.ln2g = (const float*)d_in[18]; p.ln2b = (const float*)d_in[19];
    p.out = (float*)d_out; p.ws = (unsigned char*)d_ws;
    for (int i = 0; i < 32; ++i) p.inv_freq[i] = 1.0f / powf(10000.0f, (float)(2 * i) / 64.0f);
    if (hipMemsetAsync(d_ws, 0, 16384, stream) != hipSuccess) { fprintf(stderr, "kernel_launch: memset failed\n"); return; }
#ifndef MK_LAUNCHES
#define MK_LAUNCHES 1
#endif
    for (int li = 0; li < MK_LAUNCHES; ++li) {
        p.ph_lo = (MK_LAUNCHES == 1) ? 0 : li; p.ph_hi = (MK_LAUNCHES == 1) ? 10 : li + 1;
        void* args[] = {&p};
        hipError_t e = hipLaunchCooperativeKernel((const void*)fwd_megakernel, dim3(grid_blocks), dim3(NTHR), args, LDS_BYTES, stream);
        if (e != hipSuccess) { fprintf(stderr, "cooperative launch failed: %s (grid %d)\n", hipGetErrorString(e), grid_blocks); break; }
    }
}
```

```cpp
#include <hip/hip_runtime.h>
#include <hip/hip_cooperative_groups.h>
#include <cstdio>
#include <cstdint>
#include <cmath>
namespace cg = cooperative_groups;

#define LAS __attribute__((address_space(3)))
typedef unsigned short bf16_t;
typedef short bf16x8 __attribute__((ext_vector_type(8)));
typedef float f32x4 __attribute__((ext_vector_type(4)));
typedef float f32x2 __attribute__((ext_vector_type(2)));
typedef float f32x16 __attribute__((ext_vector_type(16)));
typedef unsigned u32x4 __attribute__((ext_vector_type(4)));
typedef unsigned u32x2 __attribute__((ext_vector_type(2)));

constexpr int T = 8192, SEQ = 4096, DM = 2048, DFF = 5632, INW = 8256;
constexpr float ALPHA = 1.189207115002721f;
constexpr float LOG2E = 1.4426950408889634f;
constexpr float QS_MLA = 0.07216878364870322f * LOG2E;
constexpr float QS_DIF = 0.125f * LOG2E;
constexpr int NWAVES = 8, NTHR = 512;
constexpr int LDS_BYTES = 131072 + 64;

constexpr size_t MiB = 1u << 20;
constexpr size_t WS_ROPE = 1 * MiB;
constexpr size_t WS_SSQ = 2 * MiB, WS_SSKV = 2 * MiB + 512 * 1024;
constexpr size_t WS_WIN = 4 * MiB;
constexpr size_t WS_WDV = 33 * MiB;
constexpr size_t WS_WUQ = 37 * MiB;
constexpr size_t WS_WUK = 39 * MiB;
constexpr size_t WS_WUV = 40 * MiB;
constexpr size_t WS_WBA = 41 * MiB, WS_WBB = 45 * MiB;
constexpr size_t WS_WOUT = 49 * MiB;
constexpr size_t WS_WFI = 57 * MiB;
constexpr size_t WS_WFD = 101 * MiB;
constexpr size_t WS_XB = 124 * MiB;
constexpr size_t WS_MLAO = 124 * MiB, WS_DIFO = 140 * MiB;
constexpr size_t WS_H1B = 124 * MiB;
constexpr size_t WS_CQ = 156 * MiB, WS_CKV = 164 * MiB;
constexpr size_t WS_QD = 172 * MiB, WS_KD = 188 * MiB, WS_VDT = 204 * MiB;
constexpr size_t WS_QM = 220 * MiB, WS_KM = 244 * MiB, WS_VMT = 268 * MiB;
constexpr size_t WS_GA = 284 * MiB, WS_GB = 316 * MiB;
constexpr size_t WS_TMP = 172 * MiB;
constexpr size_t WS_MIX = 236 * MiB;
constexpr size_t WS_PRE = 284 * MiB;
constexpr size_t WS_H1 = 172 * MiB;
constexpr size_t WS_ACT = 172 * MiB;
constexpr size_t WS_END = 352 * MiB;

struct Params {
    const float* x; const float* w_in; const float* qn; const float* w_uq; const float* kvn; const float* w_ukv;
    const float* lq1; const float* lk1; const float* lq2; const float* lk2; const float* subln;
    const float* w_ba; const float* w_bb; const float* w_out; const float* ln1g; const float* ln1b;
    const float* w_fi; const float* w_fd; const float* ln2g; const float* ln2b;
    float* out; unsigned char* ws;
    float inv_freq[32];
    int ph_lo, ph_hi;
};

typedef __bf16 bf16x2_t __attribute__((ext_vector_type(2)));
__device__ __forceinline__ unsigned cvt_pk_bf16(float lo, float hi) { f32x2 v = {lo, hi}; bf16x2_t b = __builtin_convertvector(v, bf16x2_t); return __builtin_bit_cast(unsigned, b); }
__device__ __forceinline__ u32x4 pack8(f32x4 a, f32x4 b) { u32x4 w; w.x = cvt_pk_bf16(a[0], a[1]); w.y = cvt_pk_bf16(a[2], a[3]); w.z = cvt_pk_bf16(b[0], b[1]); w.w = cvt_pk_bf16(b[2], b[3]); return w; }
__device__ __forceinline__ void unpack8(u32x4 w, f32x4& a, f32x4& b) {
    a[0] = __uint_as_float(w.x << 16); a[1] = __uint_as_float(w.x & 0xffff0000u); a[2] = __uint_as_float(w.y << 16); a[3] = __uint_as_float(w.y & 0xffff0000u);
    b[0] = __uint_as_float(w.z << 16); b[1] = __uint_as_float(w.z & 0xffff0000u); b[2] = __uint_as_float(w.w << 16); b[3] = __uint_as_float(w.w & 0xffff0000u); }
__device__ __forceinline__ float sigmoidf_(float v) { return __builtin_amdgcn_rcpf(1.0f + __builtin_amdgcn_exp2f(-v * LOG2E)); }
__device__ __forceinline__ f32x4 rope4(f32x4 v, f32x4 cs) { f32x4 o; o[0] = v[0] * cs[0] - v[1] * cs[1]; o[1] = v[1] * cs[0] + v[0] * cs[1]; o[2] = v[2] * cs[2] - v[3] * cs[3]; o[3] = v[3] * cs[2] + v[2] * cs[3]; return o; }

namespace pg8 {
constexpr int BM = 256, BK = 64, HALF = 128, HTB = HALF * BK * 2, STAGE_BYTES = 8 * HTB, NXCD = 8;
__host__ __device__ __forceinline__ int lds_byte(int r, int c) { const int st = (r >> 4) * 2 + (c >> 5), rr = r & 15, cc = c & 31, ob = rr * 64 + cc * 2; return st * 1024 + (ob ^ (((ob >> 9) & 1) << 5)); }
__host__ __device__ __forceinline__ void stage_rc(int b, int& R, int& C) { const int st = b / 1024, sb = b % 1024, swz = sb ^ (((sb >> 9) & 1) << 5); R = (st >> 1) * 16 + swz / 64; C = (st & 1) * 32 + (swz % 64) / 2; }
__host__ __device__ __forceinline__ int perm32(int rho) { const int n = rho >> 4, i = rho & 15; return 8 * (i >> 2) + 4 * n + (i & 3); }

struct Unit { int pm, pn, sel; const char* a; const char* b; };

struct SegOrder {
    const bf16_t *A0, *B0, *A1, *B1, *A2, *B2; int nM0, nN0, nM1, nN1, nM2, nN2; int nwg, G, c, K;
    __device__ __forceinline__ void init(int K_, int G_, int c_) { K = K_; G = G_; c = c_; nwg = nM0 * nN0 + nM1 * nN1 + nM2 * nN2; }
    __device__ __forceinline__ bool next(int i, Unit& u) const {
        const long L = (long)i * G + c; if (L >= nwg) return false;
        int wgid = (int)L; { const int q = nwg / NXCD, r = nwg % NXCD, xcd = wgid % NXCD, off = wgid / NXCD; wgid = (xcd < r ? xcd * (q + 1) : r * (q + 1) + (xcd - r) * q) + off; }
        int nM = nM0, nN = nN0, sel = 0; uintptr_t pa = (uintptr_t)A0, pb = (uintptr_t)B0;
        if (wgid >= nM0 * nN0) { wgid -= nM0 * nN0; nM = nM1; nN = nN1; sel = 1; pa = (uintptr_t)A1; pb = (uintptr_t)B1;
            if (wgid >= nM1 * nN1) { wgid -= nM1 * nN1; nM = nM2; nN = nN2; sel = 2; pa = (uintptr_t)A2; pb = (uintptr_t)B2; } }
        const int nig = 8 * nN, gid = wgid / nig, fm = gid * 8, gsz = (nM - fm) < 8 ? (nM - fm) : 8;
        u.pm = fm + ((wgid % nig) % gsz); u.pn = (wgid % nig) / gsz; u.sel = sel;
        u.a = (const char*)(pa + (size_t)u.pm * BM * K * 2); u.b = (const char*)(pb + (size_t)u.pn * BM * K * 2); return true;
    }
    __device__ __forceinline__ const char* A(const Unit& u) const { return u.a; }
    __device__ __forceinline__ const char* B(const Unit& u) const { return u.b; }
};
struct PairOrder {
    const bf16_t *A0, *B0, *A1, *B1; int nM, nN; int nwg, G, c, K;
    __device__ __forceinline__ void init(int K_, int G_, int c_) { K = K_; G = G_; c = c_; nwg = nM * nN; }
    __device__ __forceinline__ bool next(int i, Unit& u) const {
        const long L = (long)(i >> 1) * G + c; if (L >= nwg) return false;
        int wgid = (int)L; { const int q = nwg / NXCD, r = nwg % NXCD, xcd = wgid % NXCD, off = wgid / NXCD; wgid = (xcd < r ? xcd * (q + 1) : r * (q + 1) + (xcd - r) * q) + off; }
        const int nig = 8 * nN, gid = wgid / nig, fm = gid * 8, gsz = (nM - fm) < 8 ? (nM - fm) : 8;
        u.pm = fm + ((wgid % nig) % gsz); u.pn = (wgid % nig) / gsz; u.sel = i & 1;
        u.a = (const char*)((i & 1) ? A1 : A0) + (size_t)u.pm * BM * K * 2; u.b = (const char*)((i & 1) ? B1 : B0) + (size_t)u.pn * BM * K * 2; return true;
    }
    __device__ __forceinline__ const char* A(const Unit& u) const { return u.a; }
    __device__ __forceinline__ const char* B(const Unit& u) const { return u.b; }
};

template <class Epi, class Sched>
__device__ __forceinline__ void gemm_phase(LAS unsigned char* lds, const Sched& S, const Epi& E) {
    int tid = threadIdx.x; asm volatile("" : "+v"(tid));
    const int wid = __builtin_amdgcn_readfirstlane(tid >> 6), lane = tid & 63, wr = wid >> 2, wc = wid & 3, fr = lane & 15, fq = lane >> 4;
    const int K = S.K, nt = K / BK;
    unsigned voffA[2], voffB[2];
#pragma unroll
    for (int i = 0; i < 2; ++i) { int R, C; stage_rc(tid * 16 + i * 8192, R, C); const int Rb = (R & ~31) + perm32(R & 31);
        voffA[i] = (unsigned)(R * K + C) * 2u; voffB[i] = (unsigned)(Rb * K + C) * 2u; }
    const size_t kstep = (size_t)(BK * 2);
    const size_t hstep = (size_t)HALF * K * 2;
    const unsigned ldsw = (unsigned)wid * 1024u;
    const int aoff = lds_byte(wr * 64 + fr, fq * 8), boff = lds_byte(wc * 32 + fr, fq * 8);
#define PG8_SA(b, h) (((b) * 2 + (h)) * HTB)
#define PG8_SB(b, h) ((4 + (b) * 2 + (h)) * HTB)
#define PG8_STAGE(bufoff, gbase, voff) do { _Pragma("unroll") for (int _i = 0; _i < 2; ++_i) \
        __builtin_amdgcn_global_load_lds((const unsigned*)((const char*)(gbase) + (voff)[_i]), (LAS unsigned*)(lds + (bufoff) + ldsw + _i * 8192), 16, 0, 0); } while (0)
#define PG8_LDA(dst, b, h) do { _Pragma("unroll") for (int m = 0; m < 4; ++m) _Pragma("unroll") for (int k = 0; k < 2; ++k) dst[m][k] = *(const LAS bf16x8*)(lds + PG8_SA(b, h) + aoff + m * 2048 + k * 1024); } while (0)
#define PG8_LDB(dst, b, h) do { _Pragma("unroll") for (int n = 0; n < 2; ++n) _Pragma("unroll") for (int k = 0; k < 2; ++k) dst[n][k] = *(const LAS bf16x8*)(lds + PG8_SB(b, h) + boff + n * 2048 + k * 1024); } while (0)
#define PG8_MMA(ai, bj, At, Bt) do { __builtin_amdgcn_s_setprio(1); _Pragma("unroll") for (int m = 0; m < 4; ++m) _Pragma("unroll") for (int n = 0; n < 2; ++n) _Pragma("unroll") for (int k = 0; k < 2; ++k) \
        acc[ai][bj][m][n] = __builtin_amdgcn_mfma_f32_16x16x32_bf16(Bt[n][k], At[m][k], acc[ai][bj][m][n], 0, 0, 0); __builtin_amdgcn_s_setprio(0); } while (0)
#define PG8_WAIT_V(n) asm volatile("s_waitcnt vmcnt(" #n ")" ::: "memory")
#define PG8_WAIT_L(n) asm volatile("s_waitcnt lgkmcnt(" #n ")" ::: "memory")
#define PG8_BAR __builtin_amdgcn_s_barrier()
#define PG8_SCHED __builtin_amdgcn_sched_barrier(0)
    Unit cur, nxt; int ui = 0;
    if (!S.next(0, cur)) return;
    f32x4 acc[2][2][4][2];
#pragma unroll
    for (int a = 0; a < 2; ++a)
#pragma unroll
        for (int b = 0; b < 2; ++b)
#pragma unroll
            for (int m = 0; m < 4; ++m)
#pragma unroll
                for (int n = 0; n < 2; ++n) acc[a][b][m][n] = (f32x4){0.f, 0.f, 0.f, 0.f};
    bf16x8 At[4][2], B0[2][2], B1[2][2];
    const char* cA = S.A(cur); const char* cB = S.B(cur);
    PG8_STAGE(PG8_SB(0, 0), cB, voffB); PG8_STAGE(PG8_SB(0, 1), cB + hstep, voffB); PG8_STAGE(PG8_SA(0, 0), cA, voffA); PG8_STAGE(PG8_SA(0, 1), cA + hstep, voffA);
    if (wr == 1) PG8_BAR;
    PG8_WAIT_V(2); PG8_BAR;
    PG8_STAGE(PG8_SB(1, 0), cB + kstep, voffB); PG8_STAGE(PG8_SA(1, 0), cA + kstep, voffA); PG8_STAGE(PG8_SB(1, 1), cB + hstep + kstep, voffB);
    PG8_WAIT_V(6); PG8_BAR;
    for (;;) {
        const bool has_next = S.next(ui + 1, nxt);
        const char* nA = has_next ? S.A(nxt) : cA; const char* nB = has_next ? S.B(nxt) : cB;
        for (int t = 0; t < nt; t += 2) {
            const bool last = (t == nt - 2);
            const char* a1 = cA + (size_t)(t + 1) * kstep;
            const char* a2 = last ? nA : cA + (size_t)(t + 2) * kstep; const char* b2 = last ? nB : cB + (size_t)(t + 2) * kstep;
            const char* a3 = a2 + kstep; const char* b3 = b2 + kstep;
            PG8_LDB(B0, 0, 0); PG8_LDB(B1, 0, 1); PG8_SCHED; PG8_LDA(At, 0, 0); PG8_STAGE(PG8_SA(1, 1), a1 + hstep, voffA);
            PG8_WAIT_V(8); PG8_WAIT_L(0); PG8_BAR; PG8_MMA(0, 0, At, B0); PG8_MMA(0, 1, At, B1); PG8_BAR; PG8_SCHED;
            PG8_LDA(At, 0, 1); PG8_STAGE(PG8_SB(0, 0), b2, voffB); PG8_STAGE(PG8_SB(0, 1), b2 + hstep, voffB); PG8_STAGE(PG8_SA(0, 0), a2, voffA);
            PG8_WAIT_V(8); PG8_WAIT_L(0); PG8_BAR; PG8_MMA(1, 0, At, B0); PG8_MMA(1, 1, At, B1); PG8_BAR; PG8_SCHED;
            PG8_LDB(B0, 1, 0); PG8_LDB(B1, 1, 1); PG8_SCHED; PG8_LDA(At, 1, 0); PG8_STAGE(PG8_SA(0, 1), a2 + hstep, voffA);
            PG8_WAIT_V(8); PG8_WAIT_L(0); PG8_BAR; PG8_MMA(0, 0, At, B0); PG8_MMA(0, 1, At, B1); PG8_BAR; PG8_SCHED;
            PG8_LDA(At, 1, 1); PG8_STAGE(PG8_SB(1, 0), b3, voffB); PG8_STAGE(PG8_SB(1, 1), b3 + hstep, voffB); PG8_STAGE(PG8_SA(1, 0), a3, voffA);
            PG8_WAIT_V(8); PG8_WAIT_L(0); PG8_BAR; PG8_MMA(1, 0, At, B0); PG8_MMA(1, 1, At, B1); PG8_BAR; PG8_SCHED;
        }
        if (wr == 0) PG8_BAR;
        E(acc, cur, wr, wc, fr, fq);
        if (!has_next) break;
#pragma unroll
        for (int a = 0; a < 2; ++a)
#pragma unroll
            for (int b = 0; b < 2; ++b)
#pragma unroll
                for (int m = 0; m < 4; ++m)
#pragma unroll
                    for (int n = 0; n < 2; ++n) acc[a][b][m][n] = (f32x4){0.f, 0.f, 0.f, 0.f};
        cur = nxt; cA = nA; cB = nB; ++ui;
        if (wr == 1) PG8_BAR;
    }
    PG8_WAIT_V(0);
    PG8_BAR;
#undef PG8_SA
#undef PG8_SB
#undef PG8_STAGE
#undef PG8_LDA
#undef PG8_LDB
#undef PG8_MMA
#undef PG8_WAIT_V
#undef PG8_WAIT_L
#undef PG8_BAR
#undef PG8_SCHED
}
}
using pg8::Unit;

#define EPI_ROWS(ai, m) (row0 + (ai) * 128 + (m) * 16)
typedef const f32x4 (&AccRef)[2][2][4][2];

struct EpiP1 {
    static constexpr bool PERM = true;
    bf16_t *CQ, *CKV, *QD, *KD, *VDT, *GA, *GB, *KM; float *SSQ, *SSKV; const float* ROPE;
    __device__ __forceinline__ void operator()(AccRef acc, const Unit& u, int wr, int wc, int fr, int fq) const {
        const int row0 = u.pm * 256 + wr * 64 + fr, cl = wc * 32 + 8 * fq;
        if (u.sel == 1) {
            const int t0 = u.pn * 256 + cl;
#pragma unroll
            for (int ai = 0; ai < 2; ++ai)
#pragma unroll
                for (int m = 0; m < 4; ++m) { const int r = EPI_ROWS(ai, m);
#pragma unroll
                    for (int bj = 0; bj < 2; ++bj) { const int t = t0 + bj * 128, b = t >> 12, s = t & 4095;
                        *(u32x4*)(VDT + ((size_t)(b * 1024 + r) * 4096 + s)) = pack8(acc[ai][bj][m][0], acc[ai][bj][m][1]); } }
            return;
        }
        const int pn = u.pn;
        if (pn < 4) {
            bf16_t* dst = pn < 2 ? CQ : CKV; float* ss = pn < 2 ? SSQ : SSKV; const int colt = (pn & 1) * 256 + cl;
#pragma unroll
            for (int ai = 0; ai < 2; ++ai)
#pragma unroll
                for (int m = 0; m < 4; ++m) { const int r = EPI_ROWS(ai, m); float q = 0.f;
#pragma unroll
                    for (int bj = 0; bj < 2; ++bj) { const f32x4 v0 = acc[ai][bj][m][0], v1 = acc[ai][bj][m][1];
                        q += (v0[0] * v0[0] + v0[1] * v0[1]) + (v0[2] * v0[2] + v0[3] * v0[3]) + (v1[0] * v1[0] + v1[1] * v1[1]) + (v1[2] * v1[2] + v1[3] * v1[3]);
                        *(u32x4*)(dst + (size_t)r * 512 + colt + bj * 128) = pack8(v0, v1); }
                    q += __shfl_xor(q, 16); q += __shfl_xor(q, 32);
                    if (fq == 0) ss[(size_t)r * 8 + (pn & 1) * 4 + wc] = q; }
        } else if (pn < 12) {
            const bool isq = pn < 8; bf16_t* dst = isq ? QD : KD; const int colt = (pn - (isq ? 4 : 8)) * 256 + cl; const float sc = isq ? QS_DIF : 1.0f;
#pragma unroll
            for (int ai = 0; ai < 2; ++ai)
#pragma unroll
                for (int m = 0; m < 4; ++m) { const int r = EPI_ROWS(ai, m), pos = r & 4095;
#pragma unroll
                    for (int bj = 0; bj < 2; ++bj) { const int c = colt + bj * 128, i0 = (c & 63) >> 1;
                        const f32x4* rp = (const f32x4*)(ROPE + ((size_t)pos * 32 + i0) * 2);
                        const f32x4 v0 = rope4(acc[ai][bj][m][0], rp[0]) * sc, v1 = rope4(acc[ai][bj][m][1], rp[1]) * sc;
                        *(u32x4*)(dst + (size_t)r * 1024 + c) = pack8(v0, v1); } }
        } else if (pn < 28) {
            bf16_t* dst = pn < 20 ? GA : GB; const int colt = (pn - (pn < 20 ? 12 : 20)) * 256 + cl;
#pragma unroll
            for (int ai = 0; ai < 2; ++ai)
#pragma unroll
                for (int m = 0; m < 4; ++m) { const int r = EPI_ROWS(ai, m);
#pragma unroll
                    for (int bj = 0; bj < 2; ++bj) { f32x4 v0 = acc[ai][bj][m][0], v1 = acc[ai][bj][m][1];
#pragma unroll
                        for (int e = 0; e < 4; ++e) { v0[e] = sigmoidf_(v0[e]); v1[e] = sigmoidf_(v1[e]); }
                        *(u32x4*)(dst + (size_t)r * 2048 + colt + bj * 128) = pack8(v0, v1); } }
        } else {
            if (wc < 2) {
#pragma unroll
                for (int ai = 0; ai < 2; ++ai)
#pragma unroll
                    for (int m = 0; m < 4; ++m) { const int r = EPI_ROWS(ai, m), pos = r & 4095, i0 = cl >> 1;
                        const f32x4* rp = (const f32x4*)(ROPE + ((size_t)pos * 32 + i0) * 2);
                        const u32x4 w = pack8(rope4(acc[ai][0][m][0], rp[0]), rope4(acc[ai][0][m][1], rp[1]));
#pragma unroll
                        for (int h = 0; h < 8; ++h) *(u32x4*)(KM + ((size_t)r * 8 + h) * 192 + 128 + cl) = w; }
            }
        }
    }
};

__device__ __forceinline__ float rstd512(const float* ss, int row) { const f32x4* p = (const f32x4*)(ss + (size_t)row * 8); const f32x4 a = p[0], b = p[1];
    const float s = ((a[0] + a[1]) + (a[2] + a[3])) + ((b[0] + b[1]) + (b[2] + b[3])); return __builtin_amdgcn_rsqf(s * (1.0f / 512.0f) + 1e-6f); }

struct EpiP2 {
    static constexpr bool PERM = true;
    bf16_t *QM, *KM, *VMT; const float *SSQ, *SSKV; const float* ROPE;
    __device__ __forceinline__ void operator()(AccRef acc, const Unit& u, int wr, int wc, int fr, int fq) const {
        const int row0 = u.pm * 256 + wr * 64 + fr, cl = wc * 32 + 8 * fq;
        if (u.sel == 2) {
            const int t0 = u.pn * 256 + cl; float rs[2][8];
#pragma unroll
            for (int bj = 0; bj < 2; ++bj)
#pragma unroll
                for (int e = 0; e < 8; ++e) rs[bj][e] = rstd512(SSKV, t0 + bj * 128 + e);
#pragma unroll
            for (int ai = 0; ai < 2; ++ai)
#pragma unroll
                for (int m = 0; m < 4; ++m) { const int r = EPI_ROWS(ai, m);
#pragma unroll
                    for (int bj = 0; bj < 2; ++bj) { const int t = t0 + bj * 128, b = t >> 12, s = t & 4095; f32x4 v0 = acc[ai][bj][m][0], v1 = acc[ai][bj][m][1];
#pragma unroll
                        for (int e = 0; e < 4; ++e) { v0[e] *= rs[bj][e]; v1[e] *= rs[bj][4 + e]; }
                        *(u32x4*)(VMT + ((size_t)(b * 1024 + r) * 4096 + s)) = pack8(v0, v1); } }
            return;
        }
        const int pn = u.pn;
#pragma unroll
        for (int ai = 0; ai < 2; ++ai)
#pragma unroll
            for (int m = 0; m < 4; ++m) { const int r = EPI_ROWS(ai, m), pos = r & 4095;
                const float sc = u.sel == 0 ? rstd512(SSQ, r) * QS_MLA : rstd512(SSKV, r);
#pragma unroll
                for (int bj = 0; bj < 2; ++bj) { f32x4 v0 = acc[ai][bj][m][0], v1 = acc[ai][bj][m][1];
                    if (u.sel == 0 && pn >= 4) { const int c = (pn - 4) * 256 + cl + bj * 128, h = c >> 6, w = c & 63, i0 = w >> 1;
                        const f32x4* rp = (const f32x4*)(ROPE + ((size_t)pos * 32 + i0) * 2);
                        v0 = rope4(v0, rp[0]) * sc; v1 = rope4(v1, rp[1]) * sc;
                        *(u32x4*)(QM + ((size_t)r * 8 + h) * 192 + 128 + w) = pack8(v0, v1);
                    } else { const int c = pn * 256 + cl + bj * 128, h = c >> 7, w = c & 127; bf16_t* dst = u.sel == 0 ? QM : KM;
                        v0 = v0 * sc; v1 = v1 * sc;
                        *(u32x4*)(dst + ((size_t)r * 8 + h) * 192 + w) = pack8(v0, v1); } } }
    }
};

struct EpiP4 {
    static constexpr bool PERM = true;
    const bf16_t *GA, *GB; float* TMP; bf16_t* MIX;
    __device__ __forceinline__ void operator()(AccRef acc, const Unit& u, int wr, int wc, int fr, int fq) const {
        const int row0 = u.pm * 256 + wr * 64 + fr, col0 = u.pn * 256 + wc * 32 + 8 * fq;
#pragma unroll
        for (int ai = 0; ai < 2; ++ai)
#pragma unroll
            for (int m = 0; m < 4; ++m) { const int r = EPI_ROWS(ai, m);
#pragma unroll
                for (int bj = 0; bj < 2; ++bj) { const size_t off = (size_t)r * 2048 + col0 + bj * 128; f32x4 g0, g1;
                    unpack8(*(const u32x4*)((u.sel == 0 ? GA : GB) + off), g0, g1);
                    f32x4 v0 = acc[ai][bj][m][0] * g0, v1 = acc[ai][bj][m][1] * g1;
                    if (u.sel == 0) { *(f32x4*)(TMP + off) = v0; *(f32x4*)(TMP + off + 4) = v1; }
                    else { v0 += *(const f32x4*)(TMP + off); v1 += *(const f32x4*)(TMP + off + 4); *(u32x4*)(MIX + off) = pack8(v0, v1); } } }
    }
};
struct EpiRes {
    static constexpr bool PERM = true;
    const float* BASE; float* OUT;
    __device__ __forceinline__ void operator()(AccRef acc, const Unit& u, int wr, int wc, int fr, int fq) const {
        const int row0 = u.pm * 256 + wr * 64 + fr, col0 = u.pn * 256 + wc * 32 + 8 * fq;
#pragma unroll
        for (int ai = 0; ai < 2; ++ai)
#pragma unroll
            for (int m = 0; m < 4; ++m) { const int r = EPI_ROWS(ai, m);
#pragma unroll
                for (int bj = 0; bj < 2; ++bj) { const size_t off = (size_t)r * 2048 + col0 + bj * 128;
                    const f32x4 b0 = *(const f32x4*)(BASE + off), b1 = *(const f32x4*)(BASE + off + 4);
                    *(f32x4*)(OUT + off) = b0 * ALPHA + acc[ai][bj][m][0]; *(f32x4*)(OUT + off + 4) = b1 * ALPHA + acc[ai][bj][m][1]; } }
    }
};
struct EpiResLn {
    static constexpr bool PERM = true;
    float* PRE; const float* STATS; const float* G; const float* B;
    __device__ __forceinline__ void operator()(AccRef acc, const Unit& u, int wr, int wc, int fr, int fq) const {
        const int row0 = u.pm * 256 + wr * 64 + fr, col0 = u.pn * 256 + wc * 32 + 8 * fq;
        f32x4 g[2][2], b[2][2];
#pragma unroll
        for (int bj = 0; bj < 2; ++bj) { g[bj][0] = *(const f32x4*)(G + col0 + bj * 128); g[bj][1] = *(const f32x4*)(G + col0 + bj * 128 + 4); b[bj][0] = *(const f32x4*)(B + col0 + bj * 128); b[bj][1] = *(const f32x4*)(B + col0 + bj * 128 + 4); }
#pragma unroll
        for (int ai = 0; ai < 2; ++ai)
#pragma unroll
            for (int m = 0; m < 4; ++m) { const int r = EPI_ROWS(ai, m); const f32x2 st = *(const f32x2*)(STATS + 2 * (size_t)r);
#pragma unroll
                for (int bj = 0; bj < 2; ++bj) { const size_t off = (size_t)r * 2048 + col0 + bj * 128;
                    const f32x4 p0 = *(const f32x4*)(PRE + off), p1 = *(const f32x4*)(PRE + off + 4);
                    const f32x4 h0 = (p0 - st[0]) * st[1] * g[bj][0] + b[bj][0], h1 = (p1 - st[0]) * st[1] * g[bj][1] + b[bj][1];
                    *(f32x4*)(PRE + off) = h0 * ALPHA + acc[ai][bj][m][0]; *(f32x4*)(PRE + off + 4) = h1 * ALPHA + acc[ai][bj][m][1]; } }
    }
};
struct EpiSwiGLU {
    static constexpr bool PERM = true;
    bf16_t* ACT;
    __device__ __forceinline__ void operator()(AccRef acc, const Unit& u, int wr, int wc, int fr, int fq) const {
        const int row0 = u.pm * 256 + wr * 64 + fr, col0 = u.pn * 128 + wc * 32 + 8 * fq;
#pragma unroll
        for (int ai = 0; ai < 2; ++ai)
#pragma unroll
            for (int m = 0; m < 4; ++m) { const int r = EPI_ROWS(ai, m); f32x4 v0, v1;
#pragma unroll
                for (int e = 0; e < 4; ++e) { const float g0 = acc[ai][0][m][0][e], g1 = acc[ai][0][m][1][e];
                    v0[e] = g0 * sigmoidf_(g0) * acc[ai][1][m][0][e]; v1[e] = g1 * sigmoidf_(g1) * acc[ai][1][m][1][e]; }
                *(u32x4*)(ACT + (size_t)r * DFF + col0) = pack8(v0, v1); }
    }
};

__device__ __forceinline__ unsigned f2bf(float f) { unsigned u = __builtin_bit_cast(unsigned, f); return (u + 0x7fffu + ((u >> 16) & 1u)) >> 16; }
__device__ __forceinline__ unsigned pk2(float lo, float hi) { return f2bf(lo) | (f2bf(hi) << 16); }
__device__ __forceinline__ int il64(int j) { return j < 32 ? 2 * j : 2 * (j - 32) + 1; }

__device__ __forceinline__ bf16_t* dst_row(unsigned char* ws, int mat, int c) {
    switch (mat) {
    case 0: {
        bf16_t* W = (bf16_t*)(ws + WS_WIN);
        if (c < 1024) return W + (size_t)c * 2048;
        if (c < 1088) return W + (size_t)(7168 + il64(c - 1024)) * 2048;
        if (c < 3136) { const int c2 = c - 1088; return W + (size_t)(1024 + (c2 & ~63) + il64(c2 & 63)) * 2048; }
        if (c < 4160) return (bf16_t*)(ws + WS_WDV) + (size_t)(c - 3136) * 2048;
        return W + (size_t)(3072 + (c - 4160)) * 2048; }
    case 1: {
        const int h = c / 192, w = c % 192; bf16_t* W = (bf16_t*)(ws + WS_WUQ);
        return w < 128 ? W + (size_t)(h * 128 + w) * 512 : W + (size_t)(1024 + h * 64 + il64(w - 128)) * 512; }
    case 2: {
        const int h = c >> 8, w = c & 255;
        return w < 128 ? (bf16_t*)(ws + WS_WUK) + (size_t)(h * 128 + w) * 512 : (bf16_t*)(ws + WS_WUV) + (size_t)(h * 128 + (w - 128)) * 512; }
    case 3: return (bf16_t*)(ws + WS_WBA) + (size_t)c * 1024;
    case 4: return (bf16_t*)(ws + WS_WBB) + (size_t)c * 1024;
    case 5: return (bf16_t*)(ws + WS_WOUT) + (size_t)c * 2048;
    case 6: {
        const int up = c >= DFF, cc = up ? c - DFF : c; return (bf16_t*)(ws + WS_WFI) + (size_t)((cc >> 7) * 256 + up * 128 + (cc & 127)) * 2048; }
    default: return (bf16_t*)(ws + WS_WFD) + (size_t)c * DFF;
    }
}
__device__ __forceinline__ void transpose_item(const float* W, int N, const float* gain, unsigned char* ws, int mat, LAS float* scr, int item, int lane) {
    const int nblk = N / 32, kb = item / nblk, nb = item % nblk, k0 = 64 * kb, n0 = 32 * nb;
    float tv[32];
    { const float* wp = W + (size_t)(k0 + (lane >> 5)) * N + n0 + (lane & 31);
#pragma unroll
      for (int i = 0; i < 32; ++i) tv[i] = wp[(size_t)(2 * i) * N];
      if (gain) {
#pragma unroll
          for (int i = 0; i < 32; ++i) tv[i] *= gain[k0 + 2 * i + (lane >> 5)]; }
#pragma unroll
      for (int i = 0; i < 32; ++i) scr[(2 * i + (lane >> 5)) * 33 + (lane & 31)] = tv[i]; }
    asm volatile("s_waitcnt lgkmcnt(0)" ::: "memory");
    const int c = lane & 7;
#pragma unroll
    for (int j = 0; j < 4; ++j) { const int n = (lane >> 3) + 8 * j; const LAS float* s = scr + (8 * c) * 33 + n;
        u32x4 o; o.x = pk2(s[0 * 33], s[1 * 33]); o.y = pk2(s[2 * 33], s[3 * 33]); o.z = pk2(s[4 * 33], s[5 * 33]); o.w = pk2(s[6 * 33], s[7 * 33]);
        *(u32x4*)(dst_row(ws, mat, n0 + n) + k0 + 8 * c) = o; }
    asm volatile("s_waitcnt lgkmcnt(0)" ::: "memory");
}
__device__ __forceinline__ void prologue(const Params& p, LAS unsigned char* lds, int tid, int wid, int lane) {
    LAS float* scr = (LAS float*)(lds + wid * 8704);
    const int gw = blockIdx.x * NWAVES + wid, NGW = gridDim.x * NWAVES;
    constexpr int I0 = 32 * 258, I1 = 8 * 48, I2 = 8 * 64, I3 = 16 * 64, I4 = 16 * 64, I5 = 32 * 64, I6 = 32 * 352, I7 = 88 * 64;
    constexpr int NITEMS = I0 + I1 + I2 + I3 + I4 + I5 + I6;
    for (int it = gw; it < NITEMS; it += NGW) {
        int r = it;
        if (r < I6) { transpose_item(p.w_fi, 2 * DFF, nullptr, p.ws, 6, scr, r, lane); continue; } r -= I6;
        if (r < I0) { transpose_item(p.w_in, INW, nullptr, p.ws, 0, scr, r, lane); continue; } r -= I0;
        if (r < I5) { transpose_item(p.w_out, DM, nullptr, p.ws, 5, scr, r, lane); continue; } r -= I5;
        if (r < I3) { transpose_item(p.w_ba, DM, nullptr, p.ws, 3, scr, r, lane); continue; } r -= I3;
        if (r < I4) { transpose_item(p.w_bb, DM, nullptr, p.ws, 4, scr, r, lane); continue; } r -= I4;
        if (r < I1) { transpose_item(p.w_uq, 1536, p.qn, p.ws, 1, scr, r, lane); continue; } r -= I1;
        transpose_item(p.w_ukv, 2048, p.kvn, p.ws, 2, scr, r, lane);
    }
    const int gt = blockIdx.x * NTHR + tid, NGT = gridDim.x * NTHR;
    { const f32x4* xs = (const f32x4*)p.x; u32x4* xd = (u32x4*)(p.ws + WS_XB);
      for (int i0 = gt; i0 < T * DM / 8; i0 += 4 * NGT) { f32x4 a[4], b[4];
#pragma unroll
          for (int u = 0; u < 4; ++u) { const int i = i0 + u * NGT; a[u] = xs[2 * i]; b[u] = xs[2 * i + 1]; }
#pragma unroll
          for (int u = 0; u < 4; ++u) { const int i = i0 + u * NGT; xd[i] = pack8(a[u], b[u]); } } }
    { float* rt = (float*)(p.ws + WS_ROPE);
      for (int i = gt; i < SEQ * 32; i += NGT) { const int pos = i >> 5, k = i & 31; const float ang = (float)pos * p.inv_freq[k];
          double rev = (double)ang * 0.15915494309189535; rev -= floor(rev); const float rv = (float)rev;
          rt[2 * i] = __builtin_amdgcn_cosf(rv); rt[2 * i + 1] = __builtin_amdgcn_sinf(rv); } }
}

__device__ __forceinline__ float wave_sum(float v) {
#pragma unroll
    for (int o = 1; o < 64; o <<= 1) v += __shfl_xor(v, o);
    return v;
}
template <bool BF> __device__ __forceinline__ void ln_rows(const float* in, const float* g, const float* b, float* outf, bf16_t* outb, int wid, int lane) {
    const int gw = blockIdx.x * NWAVES + wid, NGW = gridDim.x * NWAVES;
    for (int row = gw; row < T; row += NGW) {
        const f32x4* xr = (const f32x4*)(in + (size_t)row * DM) + 2 * lane;
        f32x4 v[8]; float s = 0.f;
#pragma unroll
        for (int j = 0; j < 4; ++j) { v[2 * j] = xr[128 * j]; v[2 * j + 1] = xr[128 * j + 1]; }
#pragma unroll
        for (int j = 0; j < 8; ++j) s += (v[j][0] + v[j][1]) + (v[j][2] + v[j][3]);
        const float mean = wave_sum(s) * (1.f / DM); float s2 = 0.f;
#pragma unroll
        for (int j = 0; j < 8; ++j) { v[j] = v[j] - mean; s2 += (v[j][0] * v[j][0] + v[j][1] * v[j][1]) + (v[j][2] * v[j][2] + v[j][3] * v[j][3]); }
        const float rstd = 1.0f / sqrtf(wave_sum(s2) * (1.f / DM) + 1e-5f);
#pragma unroll
        for (int j = 0; j < 4; ++j) { const int c = 512 * j + 8 * lane;
            const f32x4 g0 = *(const f32x4*)(g + c), g1 = *(const f32x4*)(g + c + 4), b0 = *(const f32x4*)(b + c), b1 = *(const f32x4*)(b + c + 4);
            const f32x4 y0 = v[2 * j] * rstd * g0 + b0, y1 = v[2 * j + 1] * rstd * g1 + b1;
            if (BF) *(u32x4*)(outb + (size_t)row * DM + c) = pack8(y0, y1);
            else { *(f32x4*)(outf + (size_t)row * DM + c) = y0; *(f32x4*)(outf + (size_t)row * DM + c + 4) = y1; } }
        if (BF && lane == 0) { outf[2 * row] = mean; outf[2 * row + 1] = rstd; }
    }
}

template <int DQK>
__device__ __forceinline__ void attn_pass(const bf16_t* __restrict__ Qg, int qstride, const bf16_t* __restrict__ Kg, int kstride, const bf16_t* __restrict__ Vt,
                                          int q0, LAS unsigned char* lds, f32x16 (&o)[4], int tid_in, int wid, int lane_in) {
    int tid = tid_in; asm volatile("" : "+v"(tid)); const int lane = tid & 63; (void)lane_in;
    constexpr int KROWB = DQK * 2 + 16, VROWB = 144, KBUF = 64 * KROWB, VBUF = 128 * VROWB, STAGE = KBUF + VBUF;
    constexpr int KCH = DQK / 8, NKL = (64 * KCH) / NTHR, ND = DQK / 16;
    static_assert(2 * STAGE <= LDS_BYTES && (64 * KCH) % NTHR == 0, "attention LDS");
    const int r32 = lane & 31, hi = lane >> 5;
    const int NT = (q0 + 256) >> 6;
    bf16x8 qf[ND];
    { const bf16_t* qrow = Qg + (size_t)(q0 + 32 * wid + r32) * qstride + 8 * hi;
#pragma unroll
      for (int dd = 0; dd < ND; ++dd) qf[dd] = *(const bf16x8*)(qrow + 16 * dd); }
    u32x4 kreg[NKL], vreg[2];
    unsigned kog[NKL], kol[NKL], vog[2], vol[2];
#pragma unroll
    for (int i = 0; i < NKL; ++i) { const int ch = tid + NTHR * i, kr = ch / KCH, kc = ch % KCH; kog[i] = (unsigned)(kr * kstride + kc * 8) * 2u; kol[i] = (unsigned)(kr * KROWB + kc * 16); }
#pragma unroll
    for (int i = 0; i < 2; ++i) { const int ch = tid + NTHR * i; vog[i] = (unsigned)((ch >> 3) * 4096 + (ch & 7) * 8) * 2u; vol[i] = (unsigned)(KBUF + (ch >> 3) * VROWB + (ch & 7) * 16); }
#define ATT_LOAD(j) do { const char* kb_ = (const char*)Kg + (size_t)(64 * (j)) * kstride * 2; const char* vb_ = (const char*)Vt + (size_t)(64 * (j)) * 2; \
        _Pragma("unroll") for (int i = 0; i < NKL; ++i) kreg[i] = *(const u32x4*)(kb_ + kog[i]); \
        _Pragma("unroll") for (int i = 0; i < 2; ++i) vreg[i] = *(const u32x4*)(vb_ + vog[i]); } while (0)
#define ATT_STORE(buf) do { LAS unsigned char* base_ = lds + (buf) * STAGE; \
        _Pragma("unroll") for (int i = 0; i < NKL; ++i) *(LAS u32x4*)(base_ + kol[i]) = kreg[i]; \
        _Pragma("unroll") for (int i = 0; i < 2; ++i) *(LAS u32x4*)(base_ + vol[i]) = vreg[i]; } while (0)
    float mrun = -INFINITY, lrun = 0.f;
#pragma unroll
    for (int d0 = 0; d0 < 4; ++d0)
#pragma unroll
        for (int r = 0; r < 16; ++r) o[d0][r] = 0.f;
    const int prow = ((r32 & ~12) | ((r32 & 4) << 1) | ((r32 & 8) >> 1));
    const int koff = prow * KROWB + 16 * hi, voff = KBUF + r32 * VROWB + 16 * hi;
    const int qg = q0 + 32 * wid + r32, qmaxw = q0 + 32 * wid + 31;
    ATT_LOAD(0); ATT_STORE(0); __syncthreads();
    for (int j = 0; j < NT; ++j) {
        if (j + 1 < NT) ATT_LOAD(j + 1);
        if (64 * j <= qmaxw) {
            LAS unsigned char* base = lds + (j & 1) * STAGE;
            f32x16 s0, s1;
#pragma unroll
            for (int r = 0; r < 16; ++r) { s0[r] = 0.f; s1[r] = 0.f; }
#pragma unroll
            for (int dd = 0; dd < ND; ++dd) {
                const bf16x8 k0 = *(const LAS bf16x8*)(base + koff + 32 * dd), k1 = *(const LAS bf16x8*)(base + koff + 32 * KROWB + 32 * dd);
                s0 = __builtin_amdgcn_mfma_f32_32x32x16_bf16(k0, qf[dd], s0, 0, 0, 0);
                s1 = __builtin_amdgcn_mfma_f32_32x32x16_bf16(k1, qf[dd], s1, 0, 0, 0);
            }
            __builtin_amdgcn_sched_group_barrier(0x100, 2, 0);
#pragma unroll
            for (int dd = 0; dd < ND - 1; ++dd) { __builtin_amdgcn_sched_group_barrier(0x100, 2, 0); __builtin_amdgcn_sched_group_barrier(0x008, 2, 0); }
            __builtin_amdgcn_sched_group_barrier(0x008, 2, 0);
            __builtin_amdgcn_sched_barrier(0);
            if (j >= NT - 4) { const int kb = 64 * j + 8 * hi;
#pragma unroll
                for (int r = 0; r < 16; ++r) { const int kv = kb + 16 * (r >> 3) + (r & 7); if (kv > qg) s0[r] = -INFINITY; if (kv + 32 > qg) s1[r] = -INFINITY; } }
            float mx = fmaxf(s0[0], s1[0]);
#pragma unroll
            for (int r = 1; r < 16; ++r) mx = fmaxf(mx, fmaxf(s0[r], s1[r]));
            mx = fmaxf(mx, __shfl_xor(mx, 32));
            if (__any(mx > mrun + 8.0f)) {
                const float mnew = fmaxf(mrun, mx), al = __builtin_amdgcn_exp2f(mrun - mnew); mrun = mnew; lrun *= al;
#pragma unroll
                for (int d0 = 0; d0 < 4; ++d0)
#pragma unroll
                    for (int r = 0; r < 16; ++r) o[d0][r] *= al;
            }
            float ps = 0.f;
#pragma unroll
            for (int r = 0; r < 16; ++r) { s0[r] = __builtin_amdgcn_exp2f(s0[r] - mrun); s1[r] = __builtin_amdgcn_exp2f(s1[r] - mrun); ps += s0[r] + s1[r]; }
            lrun += ps;
            bf16x8 pk[4];
            { u32x4 w;
              w.x = cvt_pk_bf16(s0[0], s0[1]); w.y = cvt_pk_bf16(s0[2], s0[3]); w.z = cvt_pk_bf16(s0[4], s0[5]); w.w = cvt_pk_bf16(s0[6], s0[7]); pk[0] = __builtin_bit_cast(bf16x8, w);
              w.x = cvt_pk_bf16(s0[8], s0[9]); w.y = cvt_pk_bf16(s0[10], s0[11]); w.z = cvt_pk_bf16(s0[12], s0[13]); w.w = cvt_pk_bf16(s0[14], s0[15]); pk[1] = __builtin_bit_cast(bf16x8, w);
              w.x = cvt_pk_bf16(s1[0], s1[1]); w.y = cvt_pk_bf16(s1[2], s1[3]); w.z = cvt_pk_bf16(s1[4], s1[5]); w.w = cvt_pk_bf16(s1[6], s1[7]); pk[2] = __builtin_bit_cast(bf16x8, w);
              w.x = cvt_pk_bf16(s1[8], s1[9]); w.y = cvt_pk_bf16(s1[10], s1[11]); w.z = cvt_pk_bf16(s1[12], s1[13]); w.w = cvt_pk_bf16(s1[14], s1[15]); pk[3] = __builtin_bit_cast(bf16x8, w); }
#pragma unroll
            for (int sp = 0; sp < 4; ++sp)
#pragma unroll
                for (int d0 = 0; d0 < 4; ++d0) {
                    const bf16x8 vf = *(const LAS bf16x8*)(base + voff + d0 * 32 * VROWB + 32 * sp);
                    o[d0] = __builtin_amdgcn_mfma_f32_32x32x16_bf16(vf, pk[sp], o[d0], 0, 0, 0);
                }
            __builtin_amdgcn_sched_group_barrier(0x100, 2, 0);
#pragma unroll
            for (int i = 0; i < 14; ++i) { __builtin_amdgcn_sched_group_barrier(0x008, 1, 0); __builtin_amdgcn_sched_group_barrier(0x100, 1, 0); }
            __builtin_amdgcn_sched_group_barrier(0x008, 2, 0);
            __builtin_amdgcn_sched_barrier(0);
        }
        if (j + 1 < NT) ATT_STORE((j + 1) & 1);
        __syncthreads();
    }
    lrun += __shfl_xor(lrun, 32);
    const float rl = 1.0f / lrun;
#pragma unroll
    for (int d0 = 0; d0 < 4; ++d0)
#pragma unroll
        for (int r = 0; r < 16; ++r) o[d0][r] *= rl;
#undef ATT_LOAD
#undef ATT_STORE
}
__device__ __forceinline__ void attn_store(const f32x16 (&o)[4], bf16_t* orow, int hi) {
#pragma unroll
    for (int d0 = 0; d0 < 4; ++d0)
#pragma unroll
        for (int g = 0; g < 4; ++g) { u32x2 w; w.x = cvt_pk_bf16(o[d0][4 * g], o[d0][4 * g + 1]); w.y = cvt_pk_bf16(o[d0][4 * g + 2], o[d0][4 * g + 3]);
            *(u32x2*)(orow + 32 * d0 + 8 * g + 4 * hi) = w; }
}
__device__ __forceinline__ void attention_phase(const Params& p, LAS unsigned char* lds, int tid, int wid, int lane) {
    const bf16_t* QM = (const bf16_t*)(p.ws + WS_QM); const bf16_t* KM = (const bf16_t*)(p.ws + WS_KM); const bf16_t* VMT = (const bf16_t*)(p.ws + WS_VMT);
    const bf16_t* QD = (const bf16_t*)(p.ws + WS_QD); const bf16_t* KD = (const bf16_t*)(p.ws + WS_KD); const bf16_t* VDT = (const bf16_t*)(p.ws + WS_VDT);
    bf16_t* MLAO = (bf16_t*)(p.ws + WS_MLAO); bf16_t* DIFO = (bf16_t*)(p.ws + WS_DIFO);
    const int r32 = lane & 31, hi = lane >> 5;
    for (int u = blockIdx.x; u < 256; u += gridDim.x) {
        const int bh = u >> 4, b = bh >> 3, h = bh & 7, qbm = u & 15, qbd = 15 - qbm;
        f32x16 o[4];
#ifndef ATTMASK
#define ATTMASK 3
#endif
        if (ATTMASK & 1) {
            const int q0 = qbm * 256;
            attn_pass<192>(QM + (size_t)b * SEQ * 1536 + h * 192, 1536, KM + (size_t)b * SEQ * 1536 + h * 192, 1536, VMT + (size_t)(b * 1024 + h * 128) * 4096, q0, lds, o, tid, wid, lane);
            attn_store(o, MLAO + (size_t)(b * SEQ + q0 + 32 * wid + r32) * 1024 + h * 128, hi);
        }
        if (ATTMASK & 2) {
            const int q0 = qbd * 256; unsigned o1p[4][8];
            attn_pass<64>(QD + (size_t)b * SEQ * 1024 + h * 128, 1024, KD + (size_t)b * SEQ * 1024 + h * 128, 1024, VDT + (size_t)(b * 1024 + h * 128) * 4096, q0, lds, o, tid, wid, lane);
#pragma unroll
            for (int d0 = 0; d0 < 4; ++d0)
#pragma unroll
                for (int r = 0; r < 8; ++r) o1p[d0][r] = cvt_pk_bf16(o[d0][2 * r], o[d0][2 * r + 1]);
            attn_pass<64>(QD + (size_t)b * SEQ * 1024 + h * 128 + 64, 1024, KD + (size_t)b * SEQ * 1024 + h * 128 + 64, 1024, VDT + (size_t)(b * 1024 + h * 128) * 4096, q0, lds, o, tid, wid, lane);
            const float lam = expf(wave_sum(p.lq1[lane] * p.lk1[lane])) - expf(wave_sum(p.lq2[lane] * p.lk2[lane])) + 0.2f;
            float ss = 0.f;
#pragma unroll
            for (int d0 = 0; d0 < 4; ++d0)
#pragma unroll
                for (int r = 0; r < 16; ++r) { const unsigned w = o1p[d0][r >> 1]; const float a1 = (r & 1) ? __uint_as_float(w & 0xffff0000u) : __uint_as_float(w << 16); const float v = a1 - lam * o[d0][r]; o[d0][r] = v; ss += v * v; }
            ss += __shfl_xor(ss, 32);
            const float rs = __builtin_amdgcn_rsqf(ss * (1.0f / 128.0f) + 1e-5f) * 0.8f;
#pragma unroll
            for (int d0 = 0; d0 < 4; ++d0)
#pragma unroll
                for (int g = 0; g < 4; ++g) { const f32x4 gv = *(const f32x4*)(p.subln + 32 * d0 + 8 * g + 4 * hi);
#pragma unroll
                    for (int e = 0; e < 4; ++e) o[d0][4 * g + e] *= rs * gv[e]; }
            attn_store(o, DIFO + (size_t)(b * SEQ + q0 + 32 * wid + r32) * 1024 + h * 128, hi);
        }
    }
}


__device__ __forceinline__ float bf2f(bf16_t v) { return __uint_as_float(((unsigned)v) << 16); }
#ifndef STOPAT
#define STOPAT 99
#endif
#define DUMP_BEGIN() const size_t NTOT_ = (size_t)T * DM; for (size_t i_ = (size_t)blockIdx.x * NTHR + threadIdx.x; i_ < NTOT_; i_ += (size_t)gridDim.x * NTHR) { float acc_ = 0.f;
#define DUMP_BF(off, n) acc_ += bf2f(((const bf16_t*)(ws + (off)))[i_ % (size_t)(n)]);
#define DUMP_F32(off, n) acc_ += ((const float*)(ws + (off)))[i_ % (size_t)(n)];
#define DUMP_END() p.out[i_] = acc_; } return;

__device__ __forceinline__ void krope_phase(const Params& p, LAS unsigned char* lds, int tid, int wid, int lane) {
    const bf16_t* XB = (const bf16_t*)(p.ws + WS_XB); const bf16_t* WK = (const bf16_t*)(p.ws + WS_WIN) + (size_t)7168 * 2048;
    bf16_t* KM = (bf16_t*)(p.ws + WS_KM); const float* ROPE = (const float*)(p.ws + WS_ROPE);
    const int r32 = lane & 31, hi = lane >> 5;
    LAS float* red = (LAS float*)lds;
    for (int blk = blockIdx.x; blk < T / 32; blk += gridDim.x) {
        const bf16_t* ap = XB + (size_t)(blk * 32 + r32) * 2048 + wid * 256 + 8 * hi;
        const bf16_t* bp = WK + (size_t)r32 * 2048 + wid * 256 + 8 * hi;
        f32x16 c0, c1;
#pragma unroll
        for (int r = 0; r < 16; ++r) { c0[r] = 0.f; c1[r] = 0.f; }
#pragma unroll 4
        for (int dd = 0; dd < 16; ++dd) {
            const bf16x8 a = *(const bf16x8*)(ap + 16 * dd), b0 = *(const bf16x8*)(bp + 16 * dd), b1 = *(const bf16x8*)(bp + (size_t)32 * 2048 + 16 * dd);
            c0 = __builtin_amdgcn_mfma_f32_32x32x16_bf16(a, b0, c0, 0, 0, 0);
            c1 = __builtin_amdgcn_mfma_f32_32x32x16_bf16(a, b1, c1, 0, 0, 0);
        }
#pragma unroll
        for (int r = 0; r < 16; ++r) { const int row = (r & 3) + 8 * (r >> 2) + 4 * hi;
            red[(wid * 32 + row) * 64 + r32] = c0[r]; red[(wid * 32 + row) * 64 + 32 + r32] = c1[r]; }
        __syncthreads();
        { const int row = tid >> 4, c4 = (tid & 15) * 4; f32x4 v = {0.f, 0.f, 0.f, 0.f};
#pragma unroll
          for (int w = 0; w < 8; ++w) v += *(const LAS f32x4*)(red + (w * 32 + row) * 64 + c4);
          const int t = blk * 32 + row, pos = t & 4095;
          const f32x4 cs = *(const f32x4*)(ROPE + ((size_t)pos * 32 + (c4 >> 1)) * 2);
          const f32x4 o = rope4(v, cs); u32x2 w2; w2.x = cvt_pk_bf16(o[0], o[1]); w2.y = cvt_pk_bf16(o[2], o[3]);
#pragma unroll
          for (int h = 0; h < 8; ++h) *(u32x2*)(KM + ((size_t)t * 8 + h) * 192 + 128 + c4) = w2; }
        __syncthreads();
    }
}
#define XB_TMO      128
#define XB_XCNT(j)  (256  + 64 * (j))
#define XB_XSUB(j)  (1280 + 64 * (j))
#define XB_XGEN(j)  (2304 + 64 * (j))
#define XB_TOP      3328
#define XB_TOPGEN   3392
#define XCD_BAR_WORDS 3456
#define XB_SPIN_CAP (1u << 18)

__device__ __forceinline__ unsigned xb_ld(unsigned* p)              { return __hip_atomic_load(p, __ATOMIC_RELAXED, __HIP_MEMORY_SCOPE_AGENT); }
__device__ __forceinline__ unsigned xb_add(unsigned* p, unsigned v) { return __hip_atomic_fetch_add(p, v, __ATOMIC_RELAXED, __HIP_MEMORY_SCOPE_AGENT); }
__device__ __forceinline__ unsigned xb_xcc_id() { return (unsigned)__builtin_amdgcn_s_getreg((3 << 11) | 20) & 0xFu; }
#define XB_SPIN(cond, bar) do { unsigned _sp = 0; while (cond) { __builtin_amdgcn_s_sleep(1); \
    if ((++_sp & 255u) == 0u) { if (xb_ld(&(bar)[XB_TMO])) break; if (_sp > XB_SPIN_CAP) { atomicAdd(&(bar)[XB_TMO], 1u); break; } } } } while (0)

struct XcdBarrier {
    unsigned* bar; unsigned x;
    volatile LAS unsigned* st;
};

__device__ __forceinline__ XcdBarrier xcd_barrier_post(unsigned* bar, volatile LAS unsigned* st) {
    XcdBarrier b; b.bar = bar; b.x = xb_xcc_id(); b.st = st;
    if (threadIdx.x == 0) (void)xb_add(&bar[XB_XCNT(b.x)], 1u);
    return b;
}
__device__ __forceinline__ void xcd_barrier_complete(unsigned* bar, unsigned x, unsigned& nloc, unsigned& nx) {
    const unsigned G = gridDim.x * gridDim.y * gridDim.z;
    unsigned sum, cnt, mine, sp = 0u;
    for (;;) {
        sum = 0u; cnt = 0u; mine = 0u;
#pragma unroll
        for (unsigned j = 0; j < 16; ++j) { const unsigned c = xb_ld(&bar[XB_XCNT(j)]); sum += c; cnt += (c > 0u) ? 1u : 0u; mine = (j == x) ? c : mine; }
        if (sum == G) break;
        __builtin_amdgcn_s_sleep(1);
        if ((++sp & 255u) == 0u) { if (xb_ld(&bar[XB_TMO])) break; if (sp > XB_SPIN_CAP) { atomicAdd(&bar[XB_TMO], 1u); break; } }
    }
    nloc = mine > 0u ? mine : 1u; nx = cnt > 0u ? cnt : 1u;
}

__device__ __forceinline__ void xcd_barrier(const XcdBarrier& b) {
    asm volatile("s_waitcnt vmcnt(0)" ::: "memory");
    __syncthreads();
    if (threadIdx.x == 0) {
        unsigned* bar = b.bar;
        __builtin_amdgcn_s_waitcnt(0);
        unsigned nloc = b.st[0], nx = b.st[1];
        if (nloc == 0u) { xcd_barrier_complete(bar, b.x, nloc, nx); b.st[0] = nloc; b.st[1] = nx; }
        const unsigned old = xb_add(&bar[XB_XSUB(b.x)], 1u);
        const unsigned gen = old / nloc;
        if (old + 1u == (gen + 1u) * nloc) {
            __builtin_amdgcn_fence(__ATOMIC_RELEASE, "agent");
            asm volatile("s_waitcnt vmcnt(0)" ::: "memory");
            const unsigned og = xb_add(&bar[XB_TOP], 1u);
            const unsigned tg = og / nx;
            if (og + 1u == (tg + 1u) * nx) xb_add(&bar[XB_TOPGEN], 1u);
            else XB_SPIN(xb_ld(&bar[XB_TOPGEN]) == tg, bar);
            __builtin_amdgcn_fence(__ATOMIC_ACQUIRE, "agent");
            xb_add(&bar[XB_XGEN(b.x)], 1u);
            asm volatile("s_waitcnt vmcnt(0)" ::: "memory");
        } else {
            XB_SPIN(xb_ld(&bar[XB_XGEN(b.x)]) == gen, bar);
            __builtin_amdgcn_fence(__ATOMIC_ACQUIRE, "agent");
            asm volatile("s_waitcnt vmcnt(0)" ::: "memory");
        }
    }
    __syncthreads();
}

__global__ void __launch_bounds__(NTHR, 2) fwd_megakernel(Params p) {
    extern __shared__ __attribute__((aligned(16))) unsigned char lds_raw[];
    LAS unsigned char* lds = (LAS unsigned char*)lds_raw;
    cg::grid_group grid = cg::this_grid();
    volatile LAS unsigned* bst = (volatile LAS unsigned*)(lds + 131072);
    if (threadIdx.x == 0) { bst[0] = 0u; bst[1] = 0u; }
    __syncthreads();
    XcdBarrier bar = xcd_barrier_post((unsigned*)p.ws, bst);
#define GRID_SYNC() xcd_barrier(bar)
    if (p.ph_hi - p.ph_lo > 1) grid.sync();
#define IN(k) (p.ph_lo <= (k) && (k) < p.ph_hi)
    const int tid = threadIdx.x, lane = tid & 63, wid = __builtin_amdgcn_readfirstlane(tid >> 6);
    const int G = gridDim.x, c = blockIdx.x;
    unsigned char* ws = p.ws;
    bf16_t* XB = (bf16_t*)(ws + WS_XB);
    const float* ROPE = (const float*)(ws + WS_ROPE);

    if IN(0) prologue(p, lds, tid, wid, lane);
    if (IN(0) && IN(1)) GRID_SYNC();
    if IN(1) {
        pg8::SegOrder S; S.A0 = XB; S.B0 = (const bf16_t*)(ws + WS_WIN); S.nM0 = 32; S.nN0 = 28;
        S.A1 = (const bf16_t*)(ws + WS_WDV); S.B1 = XB; S.nM1 = 4; S.nN1 = 32; S.A2 = nullptr; S.B2 = nullptr; S.nM2 = 0; S.nN2 = 0; S.init(2048, G, c);
        EpiP1 E{(bf16_t*)(ws + WS_CQ), (bf16_t*)(ws + WS_CKV), (bf16_t*)(ws + WS_QD), (bf16_t*)(ws + WS_KD), (bf16_t*)(ws + WS_VDT), (bf16_t*)(ws + WS_GA), (bf16_t*)(ws + WS_GB),
                (bf16_t*)(ws + WS_KM), (float*)(ws + WS_SSQ), (float*)(ws + WS_SSKV), ROPE};
        pg8::gemm_phase(lds, S, E);
    }
    if (IN(1) && IN(2)) GRID_SYNC();
    if IN(2) {
        krope_phase(p, lds, tid, wid, lane);
        pg8::SegOrder S; S.A0 = (const bf16_t*)(ws + WS_CQ); S.B0 = (const bf16_t*)(ws + WS_WUQ); S.nM0 = 32; S.nN0 = 6;
        S.A1 = (const bf16_t*)(ws + WS_CKV); S.B1 = (const bf16_t*)(ws + WS_WUK); S.nM1 = 32; S.nN1 = 4;
        S.A2 = (const bf16_t*)(ws + WS_WUV); S.B2 = (const bf16_t*)(ws + WS_CKV); S.nM2 = 4; S.nN2 = 32; S.init(512, G, c);
        EpiP2 E{(bf16_t*)(ws + WS_QM), (bf16_t*)(ws + WS_KM), (bf16_t*)(ws + WS_VMT), (const float*)(ws + WS_SSQ), (const float*)(ws + WS_SSKV), ROPE};
        pg8::gemm_phase(lds, S, E);
    }
    if (IN(2) && IN(3)) GRID_SYNC();
    if IN(3) attention_phase(p, lds, tid, wid, lane);
    if (IN(3) && IN(4)) GRID_SYNC();
    if IN(4) {
        pg8::PairOrder S; S.A0 = (const bf16_t*)(ws + WS_MLAO); S.B0 = (const bf16_t*)(ws + WS_WBA); S.A1 = (const bf16_t*)(ws + WS_DIFO); S.B1 = (const bf16_t*)(ws + WS_WBB);
        S.nM = 32; S.nN = 8; S.init(1024, G, c);
        EpiP4 E{(const bf16_t*)(ws + WS_GA), (const bf16_t*)(ws + WS_GB), (float*)(ws + WS_TMP), (bf16_t*)(ws + WS_MIX)};
        pg8::gemm_phase(lds, S, E);
    }
    if (IN(4) && IN(5)) GRID_SYNC();
    if IN(5) {
        pg8::SegOrder S; S.A0 = (const bf16_t*)(ws + WS_MIX); S.B0 = (const bf16_t*)(ws + WS_WOUT); S.nM0 = 32; S.nN0 = 8;
        S.A1 = S.B1 = S.A2 = S.B2 = nullptr; S.nM1 = S.nN1 = S.nM2 = S.nN2 = 0; S.init(2048, G, c);
        EpiRes E{p.x, (float*)(ws + WS_PRE)};
        pg8::gemm_phase(lds, S, E);
    }
    if (IN(5) && IN(6)) GRID_SYNC();
    if IN(6) ln_rows<true>((const float*)(ws + WS_PRE), p.ln1g, p.ln1b, (float*)(ws + WS_SSQ), (bf16_t*)(ws + WS_H1B), wid, lane);
    if (IN(6) && IN(7)) GRID_SYNC();
    if IN(7) {
        pg8::SegOrder S; S.A0 = (const bf16_t*)(ws + WS_H1B); S.B0 = (const bf16_t*)(ws + WS_WFI); S.nM0 = 32; S.nN0 = 44;
        S.A1 = S.B1 = S.A2 = S.B2 = nullptr; S.nM1 = S.nN1 = S.nM2 = S.nN2 = 0; S.init(2048, G, c);
        EpiSwiGLU E{(bf16_t*)(ws + WS_ACT)};
        pg8::gemm_phase(lds, S, E);
        { const int nfull = S.nwg % G, nidle = (nfull == 0) ? G : G - nfull, me = (nfull == 0) ? c : c - nfull;
          if (me >= 0) { LAS float* scr = (LAS float*)(lds + wid * 8704);
              for (int it = me * NWAVES + wid; it < 88 * 64; it += nidle * NWAVES) transpose_item(p.w_fd, DM, nullptr, p.ws, 7, scr, it, lane); } }
    }
    if (IN(7) && IN(8)) GRID_SYNC();
    if IN(8) {
        pg8::SegOrder S; S.A0 = (const bf16_t*)(ws + WS_ACT); S.B0 = (const bf16_t*)(ws + WS_WFD); S.nM0 = 32; S.nN0 = 8;
        S.A1 = S.B1 = S.A2 = S.B2 = nullptr; S.nM1 = S.nN1 = S.nM2 = S.nN2 = 0; S.init(DFF, G, c);
        EpiResLn E{(float*)(ws + WS_PRE), (const float*)(ws + WS_SSQ), p.ln1g, p.ln1b};
        pg8::gemm_phase(lds, S, E);
    }
    if (IN(8) && IN(9)) GRID_SYNC();
    if IN(9) ln_rows<false>((const float*)(ws + WS_PRE), p.ln2g, p.ln2b, p.out, nullptr, wid, lane);
}

extern "C" void kernel_launch(void* const* d_in, const int* in_sizes, int n_in, void* d_out, int out_size, void* d_ws, size_t ws_size, hipStream_t stream) {
    static int grid_blocks = 0;
    if (grid_blocks == 0) {
        if (n_in != 20 || in_sizes[0] != T * DM || out_size != T * DM || ws_size < WS_END) { fprintf(stderr, "kernel_launch: unexpected shapes (n_in %d, in0 %d, out %d, ws %zu)\n", n_in, n_in > 0 ? in_sizes[0] : -1, out_size, ws_size); grid_blocks = -1; return; }
        int dev = 0, cus = 0, per_cu = 0;
        (void)hipGetDevice(&dev);
        (void)hipDeviceGetAttribute(&cus, hipDeviceAttributeMultiprocessorCount, dev);
        if (hipFuncSetAttribute((const void*)fwd_megakernel, hipFuncAttributeMaxDynamicSharedMemorySize, LDS_BYTES) != hipSuccess) { fprintf(stderr, "kernel_launch: hipFuncSetAttribute failed\n"); grid_blocks = -1; return; }
        if (hipOccupancyMaxActiveBlocksPerMultiprocessor(&per_cu, (const void*)fwd_megakernel, NTHR, LDS_BYTES) != hipSuccess || per_cu < 1) { fprintf(stderr, "kernel_launch: occupancy query failed (%d)\n", per_cu); (void)hipGetLastError(); per_cu = 1; }
        grid_blocks = cus * (per_cu > 1 ? 1 : per_cu);
        if (grid_blocks > 256) grid_blocks = 256;
    }
    if (grid_blocks < 0) return;
    Params p{};
    p.x = (const float*)d_in[0]; p.w_in = (const float*)d_in[1]; p.qn = (const float*)d_in[2]; p.w_uq = (const float*)d_in[3]; p.kvn = (const float*)d_in[4]; p.w_ukv = (const float*)d_in[5];
    p.lq1 = (const float*)d_in[6]; p.lk1 = (const float*)d_in[7]; p.lq2 = (const float*)d_in[8]; p.lk2 = (const float*)d_in[9]; p.subln = (const float*)d_in[10];
    p.w_ba = (const float*)d_in[11]; p.w_bb = (const float*)d_in[12]; p.w_out = (const float*)d_in[13]; p.ln1g = (const float*)d_in[14]; p.ln1b = (const float*)d_in[15];
    p.w_fi = (const float*)d_in[16]; p.w_fd = (const float*)d_in[17]; p.ln2g = (const float*)d_in[18]; p.ln2b = (const float*)d_in[19];
    p.out = (float*)d_out; p.ws = (unsigned char*)d_ws;
    for (int i = 0; i < 32; ++i) p.inv_freq[i] = 1.0f / powf(10000.0f, (float)(2 * i) / 64.0f);
    if (hipMemsetAsync(d_ws, 0, 16384, stream) != hipSuccess) { fprintf(stderr, "kernel_launch: memset failed\n"); return; }
#ifndef MK_LAUNCHES
#define MK_LAUNCHES 1
#endif
    for (int li = 0; li < MK_LAUNCHES; ++li) {
        p.ph_lo = (MK_LAUNCHES == 1) ? 0 : li; p.ph_hi = (MK_LAUNCHES == 1) ? 10 : li + 1;
        void* args[] = {&p};
        hipError_t e = hipLaunchCooperativeKernel((const void*)fwd_megakernel, dim3(grid_blocks), dim3(NTHR), args, LDS_BYTES, stream);
        if (e != hipSuccess) { fprintf(stderr, "cooperative launch failed: %s (grid %d)\n", hipGetErrorString(e), grid_blocks); break; }
    }
}
```

```cpp
#include <hip/hip_runtime.h>
#include <hip/hip_cooperative_groups.h>
#include <cstdio>
#include <cstdint>
#include <cmath>
namespace cg = cooperative_groups;

#define LAS __attribute__((address_space(3)))
typedef unsigned short bf16_t;
typedef short bf16x8 __attribute__((ext_vector_type(8)));
typedef float f32x4 __attribute__((ext_vector_type(4)));
typedef float f32x2 __attribute__((ext_vector_type(2)));
typedef float f32x16 __attribute__((ext_vector_type(16)));
typedef unsigned u32x4 __attribute__((ext_vector_type(4)));
typedef unsigned u32x2 __attribute__((ext_vector_type(2)));

constexpr int T = 8192, SEQ = 4096, DM = 2048, DFF = 5632, INW = 8256;
constexpr float ALPHA = 1.189207115002721f;
constexpr float LOG2E = 1.4426950408889634f;
constexpr float QS_MLA = 0.07216878364870322f * LOG2E;
constexpr float QS_DIF = 0.125f * LOG2E;
constexpr int NWAVES = 8, NTHR = 512;
constexpr int LDS_BYTES = 131072 + 64;

constexpr size_t MiB = 1u << 20;
constexpr size_t WS_ROPE = 1 * MiB;
constexpr size_t WS_SSQ = 2 * MiB, WS_SSKV = 2 * MiB + 512 * 1024;
constexpr size_t WS_WIN = 4 * MiB;
constexpr size_t WS_WDV = 33 * MiB;
constexpr size_t WS_WUQ = 37 * MiB;
constexpr size_t WS_WUK = 39 * MiB;
constexpr size_t WS_WUV = 40 * MiB;
constexpr size_t WS_WBA = 41 * MiB, WS_WBB = 45 * MiB;
constexpr size_t WS_WOUT = 49 * MiB;
constexpr size_t WS_WFI = 57 * MiB;
constexpr size_t WS_WFD = 101 * MiB;
constexpr size_t WS_XB = 124 * MiB;
constexpr size_t WS_MLAO = 124 * MiB, WS_DIFO = 140 * MiB;
constexpr size_t WS_H1B = 124 * MiB;
constexpr size_t WS_CQ = 156 * MiB, WS_CKV = 164 * MiB;
constexpr size_t WS_QD = 172 * MiB, WS_KD = 188 * MiB, WS_VDT = 204 * MiB;
constexpr size_t WS_QM = 220 * MiB, WS_KM = 244 * MiB, WS_VMT = 268 * MiB;
constexpr size_t WS_GA = 284 * MiB, WS_GB = 316 * MiB;
constexpr size_t WS_TMP = 172 * MiB;
constexpr size_t WS_MIX = 236 * MiB;
constexpr size_t WS_PRE = 284 * MiB;
constexpr size_t WS_H1 = 172 * MiB;
constexpr size_t WS_ACT = 172 * MiB;
constexpr size_t WS_END = 352 * MiB;

struct Params {
    const float* x; const float* w_in; const float* qn; const float* w_uq; const float* kvn; const float* w_ukv;
    const float* lq1; const float* lk1; const float* lq2; const float* lk2; const float* subln;
    const float* w_ba; const float* w_bb; const float* w_out; const float* ln1g; const float* ln1b;
    const float* w_fi; const float* w_fd; const float* ln2g; const float* ln2b;
    float* out; unsigned char* ws;
    float inv_freq[32];
    int ph_lo, ph_hi;
    unsigned char sched[128];
};

typedef __bf16 bf16x2_t __attribute__((ext_vector_type(2)));
__device__ __forceinline__ unsigned cvt_pk_bf16(float lo, float hi) { f32x2 v = {lo, hi}; bf16x2_t b = __builtin_convertvector(v, bf16x2_t); return __builtin_bit_cast(unsigned, b); }
__device__ __forceinline__ u32x4 pack8(f32x4 a, f32x4 b) { u32x4 w; w.x = cvt_pk_bf16(a[0], a[1]); w.y = cvt_pk_bf16(a[2], a[3]); w.z = cvt_pk_bf16(b[0], b[1]); w.w = cvt_pk_bf16(b[2], b[3]); return w; }
__device__ __forceinline__ void unpack8(u32x4 w, f32x4& a, f32x4& b) {
    a[0] = __uint_as_float(w.x << 16); a[1] = __uint_as_float(w.x & 0xffff0000u); a[2] = __uint_as_float(w.y << 16); a[3] = __uint_as_float(w.y & 0xffff0000u);
    b[0] = __uint_as_float(w.z << 16); b[1] = __uint_as_float(w.z & 0xffff0000u); b[2] = __uint_as_float(w.w << 16); b[3] = __uint_as_float(w.w & 0xffff0000u); }
__device__ __forceinline__ float sigmoidf_(float v) { return __builtin_amdgcn_rcpf(1.0f + __builtin_amdgcn_exp2f(-v * LOG2E)); }
__device__ __forceinline__ f32x4 rope4(f32x4 v, f32x4 cs) { f32x4 o; o[0] = v[0] * cs[0] - v[1] * cs[1]; o[1] = v[1] * cs[0] + v[0] * cs[1]; o[2] = v[2] * cs[2] - v[3] * cs[3]; o[3] = v[3] * cs[2] + v[2] * cs[3]; return o; }

namespace pg8 {
constexpr int BM = 256, BK = 64, HALF = 128, HTB = HALF * BK * 2, STAGE_BYTES = 8 * HTB, NXCD = 8;
__host__ __device__ __forceinline__ int lds_byte(int r, int c) { const int st = (r >> 4) * 2 + (c >> 5), rr = r & 15, cc = c & 31, ob = rr * 64 + cc * 2; return st * 1024 + (ob ^ (((ob >> 9) & 1) << 5)); }
__host__ __device__ __forceinline__ void stage_rc(int b, int& R, int& C) { const int st = b / 1024, sb = b % 1024, swz = sb ^ (((sb >> 9) & 1) << 5); R = (st >> 1) * 16 + swz / 64; C = (st & 1) * 32 + (swz % 64) / 2; }
__host__ __device__ __forceinline__ int perm32(int rho) { const int n = rho >> 4, i = rho & 15; return 8 * (i >> 2) + 4 * n + (i & 3); }

struct Unit { int pm, pn, sel; const char* a; const char* b; };

struct SegOrder {
    const bf16_t *A0, *B0, *A1, *B1, *A2, *B2; int nM0, nN0, nM1, nN1, nM2, nN2; int nwg, G, c, K;
    __device__ __forceinline__ void init(int K_, int G_, int c_) { K = K_; G = G_; c = c_; nwg = nM0 * nN0 + nM1 * nN1 + nM2 * nN2; }
    __device__ __forceinline__ bool next(int i, Unit& u) const {
        const long L = (long)i * G + c; if (L >= nwg) return false;
        int wgid = (int)L; { const int q = nwg / NXCD, r = nwg % NXCD, xcd = wgid % NXCD, off = wgid / NXCD; wgid = (xcd < r ? xcd * (q + 1) : r * (q + 1) + (xcd - r) * q) + off; }
        int nM = nM0, nN = nN0, sel = 0; uintptr_t pa = (uintptr_t)A0, pb = (uintptr_t)B0;
        if (wgid >= nM0 * nN0) { wgid -= nM0 * nN0; nM = nM1; nN = nN1; sel = 1; pa = (uintptr_t)A1; pb = (uintptr_t)B1;
            if (wgid >= nM1 * nN1) { wgid -= nM1 * nN1; nM = nM2; nN = nN2; sel = 2; pa = (uintptr_t)A2; pb = (uintptr_t)B2; } }
        const int nig = 8 * nN, gid = wgid / nig, fm = gid * 8, gsz = (nM - fm) < 8 ? (nM - fm) : 8;
        u.pm = fm + ((wgid % nig) % gsz); u.pn = (wgid % nig) / gsz; u.sel = sel;
        u.a = (const char*)(pa + (size_t)u.pm * BM * K * 2); u.b = (const char*)(pb + (size_t)u.pn * BM * K * 2); return true;
    }
    __device__ __forceinline__ const char* A(const Unit& u) const { return u.a; }
    __device__ __forceinline__ const char* B(const Unit& u) const { return u.b; }
};
struct PairOrder {
    const bf16_t *A0, *B0, *A1, *B1; int nM, nN; int nwg, G, c, K;
    __device__ __forceinline__ void init(int K_, int G_, int c_) { K = K_; G = G_; c = c_; nwg = nM * nN; }
    __device__ __forceinline__ bool next(int i, Unit& u) const {
        const long L = (long)(i >> 1) * G + c; if (L >= nwg) return false;
        int wgid = (int)L; { const int q = nwg / NXCD, r = nwg % NXCD, xcd = wgid % NXCD, off = wgid / NXCD; wgid = (xcd < r ? xcd * (q + 1) : r * (q + 1) + (xcd - r) * q) + off; }
        const int nig = 8 * nN, gid = wgid / nig, fm = gid * 8, gsz = (nM - fm) < 8 ? (nM - fm) : 8;
        u.pm = fm + ((wgid % nig) % gsz); u.pn = (wgid % nig) / gsz; u.sel = i & 1;
        u.a = (const char*)((i & 1) ? A1 : A0) + (size_t)u.pm * BM * K * 2; u.b = (const char*)((i & 1) ? B1 : B0) + (size_t)u.pn * BM * K * 2; return true;
    }
    __device__ __forceinline__ const char* A(const Unit& u) const { return u.a; }
    __device__ __forceinline__ const char* B(const Unit& u) const { return u.b; }
};

template <class Epi, class Sched>
__device__ __forceinline__ void gemm_phase(LAS unsigned char* lds, const Sched& S, const Epi& E) {
    int tid = threadIdx.x; asm volatile("" : "+v"(tid));
    const int wid = __builtin_amdgcn_readfirstlane(tid >> 6), lane = tid & 63, wr = wid >> 2, wc = wid & 3, fr = lane & 15, fq = lane >> 4;
    const int K = S.K, nt = K / BK;
    unsigned voffA[2], voffB[2];
#pragma unroll
    for (int i = 0; i < 2; ++i) { int R, C; stage_rc(tid * 16 + i * 8192, R, C); const int Rb = (R & ~31) + perm32(R & 31);
        voffA[i] = (unsigned)(R * K + C) * 2u; voffB[i] = (unsigned)(Rb * K + C) * 2u; }
    const size_t kstep = (size_t)(BK * 2);
    const size_t hstep = (size_t)HALF * K * 2;
    const unsigned ldsw = (unsigned)wid * 1024u;
    const int aoff = lds_byte(wr * 64 + fr, fq * 8), boff = lds_byte(wc * 32 + fr, fq * 8);
#define PG8_SA(b, h) (((b) * 2 + (h)) * HTB)
#define PG8_SB(b, h) ((4 + (b) * 2 + (h)) * HTB)
#define PG8_STAGE(bufoff, gbase, voff) do { _Pragma("unroll") for (int _i = 0; _i < 2; ++_i) \
        __builtin_amdgcn_global_load_lds((const unsigned*)((const char*)(gbase) + (voff)[_i]), (LAS unsigned*)(lds + (bufoff) + ldsw + _i * 8192), 16, 0, 0); } while (0)
#define PG8_LDA(dst, b, h) do { _Pragma("unroll") for (int m = 0; m < 4; ++m) _Pragma("unroll") for (int k = 0; k < 2; ++k) dst[m][k] = *(const LAS bf16x8*)(lds + PG8_SA(b, h) + aoff + m * 2048 + k * 1024); } while (0)
#define PG8_LDB(dst, b, h) do { _Pragma("unroll") for (int n = 0; n < 2; ++n) _Pragma("unroll") for (int k = 0; k < 2; ++k) dst[n][k] = *(const LAS bf16x8*)(lds + PG8_SB(b, h) + boff + n * 2048 + k * 1024); } while (0)
#define PG8_MMA(ai, bj, At, Bt) do { __builtin_amdgcn_s_setprio(1); _Pragma("unroll") for (int m = 0; m < 4; ++m) _Pragma("unroll") for (int n = 0; n < 2; ++n) _Pragma("unroll") for (int k = 0; k < 2; ++k) \
        acc[ai][bj][m][n] = __builtin_amdgcn_mfma_f32_16x16x32_bf16(Bt[n][k], At[m][k], acc[ai][bj][m][n], 0, 0, 0); __builtin_amdgcn_s_setprio(0); } while (0)
#define PG8_WAIT_V(n) asm volatile("s_waitcnt vmcnt(" #n ")" ::: "memory")
#define PG8_WAIT_L(n) asm volatile("s_waitcnt lgkmcnt(" #n ")" ::: "memory")
#define PG8_BAR __builtin_amdgcn_s_barrier()
#define PG8_SCHED __builtin_amdgcn_sched_barrier(0)
    Unit cur, nxt; int ui = 0;
    if (!S.next(0, cur)) return;
    f32x4 acc[2][2][4][2];
#pragma unroll
    for (int a = 0; a < 2; ++a)
#pragma unroll
        for (int b = 0; b < 2; ++b)
#pragma unroll
            for (int m = 0; m < 4; ++m)
#pragma unroll
                for (int n = 0; n < 2; ++n) acc[a][b][m][n] = (f32x4){0.f, 0.f, 0.f, 0.f};
    bf16x8 At[4][2], B0[2][2], B1[2][2];
    const char* cA = S.A(cur); const char* cB = S.B(cur);
    PG8_STAGE(PG8_SB(0, 0), cB, voffB); PG8_STAGE(PG8_SB(0, 1), cB + hstep, voffB); PG8_STAGE(PG8_SA(0, 0), cA, voffA); PG8_STAGE(PG8_SA(0, 1), cA + hstep, voffA);
    if (wr == 1) PG8_BAR;
    PG8_WAIT_V(2); PG8_BAR;
    PG8_STAGE(PG8_SB(1, 0), cB + kstep, voffB); PG8_STAGE(PG8_SA(1, 0), cA + kstep, voffA); PG8_STAGE(PG8_SB(1, 1), cB + hstep + kstep, voffB);
    PG8_WAIT_V(6); PG8_BAR;
    for (;;) {
        const bool has_next = S.next(ui + 1, nxt);
        const char* nA = has_next ? S.A(nxt) : cA; const char* nB = has_next ? S.B(nxt) : cB;
        for (int t = 0; t < nt; t += 2) {
            const bool last = (t == nt - 2);
            const char* a1 = cA + (size_t)(t + 1) * kstep;
            const char* a2 = last ? nA : cA + (size_t)(t + 2) * kstep; const char* b2 = last ? nB : cB + (size_t)(t + 2) * kstep;
            const char* a3 = a2 + kstep; const char* b3 = b2 + kstep;
            PG8_LDB(B0, 0, 0); PG8_LDB(B1, 0, 1); PG8_SCHED; PG8_LDA(At, 0, 0); PG8_STAGE(PG8_SA(1, 1), a1 + hstep, voffA);
            PG8_WAIT_V(8); PG8_WAIT_L(0); PG8_BAR; PG8_MMA(0, 0, At, B0); PG8_MMA(0, 1, At, B1); PG8_BAR; PG8_SCHED;
            PG8_LDA(At, 0, 1); PG8_STAGE(PG8_SB(0, 0), b2, voffB); PG8_STAGE(PG8_SB(0, 1), b2 + hstep, voffB); PG8_STAGE(PG8_SA(0, 0), a2, voffA);
            PG8_WAIT_V(8); PG8_WAIT_L(0); PG8_BAR; PG8_MMA(1, 0, At, B0); PG8_MMA(1, 1, At, B1); PG8_BAR; PG8_SCHED;
            PG8_LDB(B0, 1, 0); PG8_LDB(B1, 1, 1); PG8_SCHED; PG8_LDA(At, 1, 0); PG8_STAGE(PG8_SA(0, 1), a2 + hstep, voffA);
            PG8_WAIT_V(8); PG8_WAIT_L(0); PG8_BAR; PG8_MMA(0, 0, At, B0); PG8_MMA(0, 1, At, B1); PG8_BAR; PG8_SCHED;
            PG8_LDA(At, 1, 1); PG8_STAGE(PG8_SB(1, 0), b3, voffB); PG8_STAGE(PG8_SB(1, 1), b3 + hstep, voffB); PG8_STAGE(PG8_SA(1, 0), a3, voffA);
            PG8_WAIT_V(8); PG8_WAIT_L(0); PG8_BAR; PG8_MMA(1, 0, At, B0); PG8_MMA(1, 1, At, B1); PG8_BAR; PG8_SCHED;
        }
        if (wr == 0) PG8_BAR;
        E(acc, cur, wr, wc, fr, fq);
        if (!has_next) break;
#pragma unroll
        for (int a = 0; a < 2; ++a)
#pragma unroll
            for (int b = 0; b < 2; ++b)
#pragma unroll
                for (int m = 0; m < 4; ++m)
#pragma unroll
                    for (int n = 0; n < 2; ++n) acc[a][b][m][n] = (f32x4){0.f, 0.f, 0.f, 0.f};
        cur = nxt; cA = nA; cB = nB; ++ui;
        if (wr == 1) PG8_BAR;
    }
    PG8_WAIT_V(0);
    PG8_BAR;
#undef PG8_SA
#undef PG8_SB
#undef PG8_STAGE
#undef PG8_LDA
#undef PG8_LDB
#undef PG8_MMA
#undef PG8_WAIT_V
#undef PG8_WAIT_L
#undef PG8_BAR
#undef PG8_SCHED
}
}
using pg8::Unit;

#define EPI_ROWS(ai, m) (row0 + (ai) * 128 + (m) * 16)
typedef const f32x4 (&AccRef)[2][2][4][2];

struct EpiP1 {
    static constexpr bool PERM = true;
    bf16_t *CQ, *CKV, *QD, *KD, *VDT, *GA, *GB, *KM; float *SSQ, *SSKV; const float* ROPE;
    __device__ __forceinline__ void operator()(AccRef acc, const Unit& u, int wr, int wc, int fr, int fq) const {
        const int row0 = u.pm * 256 + wr * 64 + fr, cl = wc * 32 + 8 * fq;
        if (u.sel == 1) {
            const int t0 = u.pn * 256 + cl;
#pragma unroll
            for (int ai = 0; ai < 2; ++ai)
#pragma unroll
                for (int m = 0; m < 4; ++m) { const int r = EPI_ROWS(ai, m);
#pragma unroll
                    for (int bj = 0; bj < 2; ++bj) { const int t = t0 + bj * 128, b = t >> 12, s = t & 4095;
                        *(u32x4*)(VDT + ((size_t)(b * 1024 + r) * 4096 + s)) = pack8(acc[ai][bj][m][0], acc[ai][bj][m][1]); } }
            return;
        }
        const int pn = u.pn;
        if (pn < 4) {
            bf16_t* dst = pn < 2 ? CQ : CKV; float* ss = pn < 2 ? SSQ : SSKV; const int colt = (pn & 1) * 256 + cl;
#pragma unroll
            for (int ai = 0; ai < 2; ++ai)
#pragma unroll
                for (int m = 0; m < 4; ++m) { const int r = EPI_ROWS(ai, m); float q = 0.f;
#pragma unroll
                    for (int bj = 0; bj < 2; ++bj) { const f32x4 v0 = acc[ai][bj][m][0], v1 = acc[ai][bj][m][1];
                        q += (v0[0] * v0[0] + v0[1] * v0[1]) + (v0[2] * v0[2] + v0[3] * v0[3]) + (v1[0] * v1[0] + v1[1] * v1[1]) + (v1[2] * v1[2] + v1[3] * v1[3]);
                        *(u32x4*)(dst + (size_t)r * 512 + colt + bj * 128) = pack8(v0, v1); }
                    q += __shfl_xor(q, 16); q += __shfl_xor(q, 32);
                    if (fq == 0) ss[(size_t)r * 8 + (pn & 1) * 4 + wc] = q; }
        } else if (pn < 12) {
            const bool isq = pn < 8; bf16_t* dst = isq ? QD : KD; const int colt = (pn - (isq ? 4 : 8)) * 256 + cl; const float sc = isq ? QS_DIF : 1.0f;
#pragma unroll
            for (int ai = 0; ai < 2; ++ai)
#pragma unroll
                for (int m = 0; m < 4; ++m) { const int r = EPI_ROWS(ai, m), pos = r & 4095;
#pragma unroll
                    for (int bj = 0; bj < 2; ++bj) { const int c = colt + bj * 128, i0 = (c & 63) >> 1;
                        const f32x4* rp = (const f32x4*)(ROPE + ((size_t)pos * 32 + i0) * 2);
                        const f32x4 v0 = rope4(acc[ai][bj][m][0], rp[0]) * sc, v1 = rope4(acc[ai][bj][m][1], rp[1]) * sc;
                        *(u32x4*)(dst + (size_t)r * 1024 + c) = pack8(v0, v1); } }
        } else if (pn < 28) {
            bf16_t* dst = pn < 20 ? GA : GB; const int colt = (pn - (pn < 20 ? 12 : 20)) * 256 + cl;
#pragma unroll
            for (int ai = 0; ai < 2; ++ai)
#pragma unroll
                for (int m = 0; m < 4; ++m) { const int r = EPI_ROWS(ai, m);
#pragma unroll
                    for (int bj = 0; bj < 2; ++bj) { f32x4 v0 = acc[ai][bj][m][0], v1 = acc[ai][bj][m][1];
#pragma unroll
                        for (int e = 0; e < 4; ++e) { v0[e] = sigmoidf_(v0[e]); v1[e] = sigmoidf_(v1[e]); }
                        *(u32x4*)(dst + (size_t)r * 2048 + colt + bj * 128) = pack8(v0, v1); } }
        } else {
            if (wc < 2) {
#pragma unroll
                for (int ai = 0; ai < 2; ++ai)
#pragma unroll
                    for (int m = 0; m < 4; ++m) { const int r = EPI_ROWS(ai, m), pos = r & 4095, i0 = cl >> 1;
                        const f32x4* rp = (const f32x4*)(ROPE + ((size_t)pos * 32 + i0) * 2);
                        const u32x4 w = pack8(rope4(acc[ai][0][m][0], rp[0]), rope4(acc[ai][0][m][1], rp[1]));
#pragma unroll
                        for (int h = 0; h < 8; ++h) *(u32x4*)(KM + ((size_t)r * 8 + h) * 192 + 128 + cl) = w; }
            }
        }
    }
};

__device__ __forceinline__ float rstd512(const float* ss, int row) { const f32x4* p = (const f32x4*)(ss + (size_t)row * 8); const f32x4 a = p[0], b = p[1];
    const float s = ((a[0] + a[1]) + (a[2] + a[3])) + ((b[0] + b[1]) + (b[2] + b[3])); return __builtin_amdgcn_rsqf(s * (1.0f / 512.0f) + 1e-6f); }

struct EpiP2 {
    static constexpr bool PERM = true;
    bf16_t *QM, *KM, *VMT; const float *SSQ, *SSKV; const float* ROPE;
    __device__ __forceinline__ void operator()(AccRef acc, const Unit& u, int wr, int wc, int fr, int fq) const {
        const int row0 = u.pm * 256 + wr * 64 + fr, cl = wc * 32 + 8 * fq;
        if (u.sel == 2) {
            const int t0 = u.pn * 256 + cl; float rs[2][8];
#pragma unroll
            for (int bj = 0; bj < 2; ++bj)
#pragma unroll
                for (int e = 0; e < 8; ++e) rs[bj][e] = rstd512(SSKV, t0 + bj * 128 + e);
#pragma unroll
            for (int ai = 0; ai < 2; ++ai)
#pragma unroll
                for (int m = 0; m < 4; ++m) { const int r = EPI_ROWS(ai, m);
#pragma unroll
                    for (int bj = 0; bj < 2; ++bj) { const int t = t0 + bj * 128, b = t >> 12, s = t & 4095; f32x4 v0 = acc[ai][bj][m][0], v1 = acc[ai][bj][m][1];
#pragma unroll
                        for (int e = 0; e < 4; ++e) { v0[e] *= rs[bj][e]; v1[e] *= rs[bj][4 + e]; }
                        *(u32x4*)(VMT + ((size_t)(b * 1024 + r) * 4096 + s)) = pack8(v0, v1); } }
            return;
        }
        const int pn = u.pn;
#pragma unroll
        for (int ai = 0; ai < 2; ++ai)
#pragma unroll
            for (int m = 0; m < 4; ++m) { const int r = EPI_ROWS(ai, m), pos = r & 4095;
                const float sc = u.sel == 0 ? rstd512(SSQ, r) * QS_MLA : rstd512(SSKV, r);
#pragma unroll
                for (int bj = 0; bj < 2; ++bj) { f32x4 v0 = acc[ai][bj][m][0], v1 = acc[ai][bj][m][1];
                    if (u.sel == 0 && pn >= 4) { const int c = (pn - 4) * 256 + cl + bj * 128, h = c >> 6, w = c & 63, i0 = w >> 1;
                        const f32x4* rp = (const f32x4*)(ROPE + ((size_t)pos * 32 + i0) * 2);
                        v0 = rope4(v0, rp[0]) * sc; v1 = rope4(v1, rp[1]) * sc;
                        *(u32x4*)(QM + ((size_t)r * 8 + h) * 192 + 128 + w) = pack8(v0, v1);
                    } else { const int c = pn * 256 + cl + bj * 128, h = c >> 7, w = c & 127; bf16_t* dst = u.sel == 0 ? QM : KM;
                        v0 = v0 * sc; v1 = v1 * sc;
                        *(u32x4*)(dst + ((size_t)r * 8 + h) * 192 + w) = pack8(v0, v1); } } }
    }
};

struct EpiP4 {
    static constexpr bool PERM = true;
    const bf16_t *GA, *GB; float* TMP; bf16_t* MIX;
    __device__ __forceinline__ void operator()(AccRef acc, const Unit& u, int wr, int wc, int fr, int fq) const {
        const int row0 = u.pm * 256 + wr * 64 + fr, col0 = u.pn * 256 + wc * 32 + 8 * fq;
#pragma unroll
        for (int ai = 0; ai < 2; ++ai)
#pragma unroll
            for (int m = 0; m < 4; ++m) { const int r = EPI_ROWS(ai, m);
#pragma unroll
                for (int bj = 0; bj < 2; ++bj) { const size_t off = (size_t)r * 2048 + col0 + bj * 128; f32x4 g0, g1;
                    unpack8(*(const u32x4*)((u.sel == 0 ? GA : GB) + off), g0, g1);
                    f32x4 v0 = acc[ai][bj][m][0] * g0, v1 = acc[ai][bj][m][1] * g1;
                    if (u.sel == 0) { *(f32x4*)(TMP + off) = v0; *(f32x4*)(TMP + off + 4) = v1; }
                    else { v0 += *(const f32x4*)(TMP + off); v1 += *(const f32x4*)(TMP + off + 4); *(u32x4*)(MIX + off) = pack8(v0, v1); } } }
    }
};
struct EpiRes {
    static constexpr bool PERM = true;
    const float* BASE; float* OUT;
    __device__ __forceinline__ void operator()(AccRef acc, const Unit& u, int wr, int wc, int fr, int fq) const {
        const int row0 = u.pm * 256 + wr * 64 + fr, col0 = u.pn * 256 + wc * 32 + 8 * fq;
#pragma unroll
        for (int ai = 0; ai < 2; ++ai)
#pragma unroll
            for (int m = 0; m < 4; ++m) { const int r = EPI_ROWS(ai, m);
#pragma unroll
                for (int bj = 0; bj < 2; ++bj) { const size_t off = (size_t)r * 2048 + col0 + bj * 128;
                    const f32x4 b0 = *(const f32x4*)(BASE + off), b1 = *(const f32x4*)(BASE + off + 4);
                    *(f32x4*)(OUT + off) = b0 * ALPHA + acc[ai][bj][m][0]; *(f32x4*)(OUT + off + 4) = b1 * ALPHA + acc[ai][bj][m][1]; } }
    }
};
struct EpiResLn {
    static constexpr bool PERM = true;
    float* PRE; const float* STATS; const float* G; const float* B;
    __device__ __forceinline__ void operator()(AccRef acc, const Unit& u, int wr, int wc, int fr, int fq) const {
        const int row0 = u.pm * 256 + wr * 64 + fr, col0 = u.pn * 256 + wc * 32 + 8 * fq;
        f32x4 g[2][2], b[2][2];
#pragma unroll
        for (int bj = 0; bj < 2; ++bj) { g[bj][0] = *(const f32x4*)(G + col0 + bj * 128); g[bj][1] = *(const f32x4*)(G + col0 + bj * 128 + 4); b[bj][0] = *(const f32x4*)(B + col0 + bj * 128); b[bj][1] = *(const f32x4*)(B + col0 + bj * 128 + 4); }
#pragma unroll
        for (int ai = 0; ai < 2; ++ai)
#pragma unroll
            for (int m = 0; m < 4; ++m) { const int r = EPI_ROWS(ai, m); const f32x2 st = *(const f32x2*)(STATS + 2 * (size_t)r);
#pragma unroll
                for (int bj = 0; bj < 2; ++bj) { const size_t off = (size_t)r * 2048 + col0 + bj * 128;
                    const f32x4 p0 = *(const f32x4*)(PRE + off), p1 = *(const f32x4*)(PRE + off + 4);
                    const f32x4 h0 = (p0 - st[0]) * st[1] * g[bj][0] + b[bj][0], h1 = (p1 - st[0]) * st[1] * g[bj][1] + b[bj][1];
                    *(f32x4*)(PRE + off) = h0 * ALPHA + acc[ai][bj][m][0]; *(f32x4*)(PRE + off + 4) = h1 * ALPHA + acc[ai][bj][m][1]; } }
    }
};
struct EpiSwiGLU {
    static constexpr bool PERM = true;
    bf16_t* ACT;
    __device__ __forceinline__ void operator()(AccRef acc, const Unit& u, int wr, int wc, int fr, int fq) const {
        const int row0 = u.pm * 256 + wr * 64 + fr, col0 = u.pn * 128 + wc * 32 + 8 * fq;
#pragma unroll
        for (int ai = 0; ai < 2; ++ai)
#pragma unroll
            for (int m = 0; m < 4; ++m) { const int r = EPI_ROWS(ai, m); f32x4 v0, v1;
#pragma unroll
                for (int e = 0; e < 4; ++e) { const float g0 = acc[ai][0][m][0][e], g1 = acc[ai][0][m][1][e];
                    v0[e] = g0 * sigmoidf_(g0) * acc[ai][1][m][0][e]; v1[e] = g1 * sigmoidf_(g1) * acc[ai][1][m][1][e]; }
                *(u32x4*)(ACT + (size_t)r * DFF + col0) = pack8(v0, v1); }
    }
};

__device__ __forceinline__ unsigned f2bf(float f) { unsigned u = __builtin_bit_cast(unsigned, f); return (u + 0x7fffu + ((u >> 16) & 1u)) >> 16; }
__device__ __forceinline__ unsigned pk2(float lo, float hi) { return f2bf(lo) | (f2bf(hi) << 16); }
__device__ __forceinline__ int il64(int j) { return j < 32 ? 2 * j : 2 * (j - 32) + 1; }

__device__ __forceinline__ bf16_t* dst_row(unsigned char* ws, int mat, int c) {
    switch (mat) {
    case 0: {
        bf16_t* W = (bf16_t*)(ws + WS_WIN);
        if (c < 1024) return W + (size_t)c * 2048;
        if (c < 1088) return W + (size_t)(7168 + il64(c - 1024)) * 2048;
        if (c < 3136) { const int c2 = c - 1088; return W + (size_t)(1024 + (c2 & ~63) + il64(c2 & 63)) * 2048; }
        if (c < 4160) return (bf16_t*)(ws + WS_WDV) + (size_t)(c - 3136) * 2048;
        return W + (size_t)(3072 + (c - 4160)) * 2048; }
    case 1: {
        const int h = c / 192, w = c % 192; bf16_t* W = (bf16_t*)(ws + WS_WUQ);
        return w < 128 ? W + (size_t)(h * 128 + w) * 512 : W + (size_t)(1024 + h * 64 + il64(w - 128)) * 512; }
    case 2: {
        const int h = c >> 8, w = c & 255;
        return w < 128 ? (bf16_t*)(ws + WS_WUK) + (size_t)(h * 128 + w) * 512 : (bf16_t*)(ws + WS_WUV) + (size_t)(h * 128 + (w - 128)) * 512; }
    case 3: return (bf16_t*)(ws + WS_WBA) + (size_t)c * 1024;
    case 4: return (bf16_t*)(ws + WS_WBB) + (size_t)c * 1024;
    case 5: return (bf16_t*)(ws + WS_WOUT) + (size_t)c * 2048;
    case 6: {
        const int up = c >= DFF, cc = up ? c - DFF : c; return (bf16_t*)(ws + WS_WFI) + (size_t)((cc >> 7) * 256 + up * 128 + (cc & 127)) * 2048; }
    default: return (bf16_t*)(ws + WS_WFD) + (size_t)c * DFF;
    }
}
__device__ __forceinline__ void transpose_item(const float* W, int N, const float* gain, unsigned char* ws, int mat, LAS float* scr, int item, int lane) {
    const int nblk = N / 32, kb = item / nblk, nb = item % nblk, k0 = 64 * kb, n0 = 32 * nb;
    float tv[32];
    { const float* wp = W + (size_t)(k0 + (lane >> 5)) * N + n0 + (lane & 31);
#pragma unroll
      for (int i = 0; i < 32; ++i) tv[i] = wp[(size_t)(2 * i) * N];
      if (gain) {
#pragma unroll
          for (int i = 0; i < 32; ++i) tv[i] *= gain[k0 + 2 * i + (lane >> 5)]; }
#pragma unroll
      for (int i = 0; i < 32; ++i) scr[(2 * i + (lane >> 5)) * 33 + (lane & 31)] = tv[i]; }
    asm volatile("s_waitcnt lgkmcnt(0)" ::: "memory");
    const int c = lane & 7;
#pragma unroll
    for (int j = 0; j < 4; ++j) { const int n = (lane >> 3) + 8 * j; const LAS float* s = scr + (8 * c) * 33 + n;
        u32x4 o; o.x = pk2(s[0 * 33], s[1 * 33]); o.y = pk2(s[2 * 33], s[3 * 33]); o.z = pk2(s[4 * 33], s[5 * 33]); o.w = pk2(s[6 * 33], s[7 * 33]);
        *(u32x4*)(dst_row(ws, mat, n0 + n) + k0 + 8 * c) = o; }
    asm volatile("s_waitcnt lgkmcnt(0)" ::: "memory");
}
__device__ __forceinline__ void prologue(const Params& p, LAS unsigned char* lds, int tid, int wid, int lane) {
    LAS float* scr = (LAS float*)(lds + wid * 8704);
    const int gw = blockIdx.x * NWAVES + wid, NGW = gridDim.x * NWAVES;
    constexpr int I0 = 32 * 258, I1 = 8 * 48, I2 = 8 * 64, I3 = 16 * 64, I4 = 16 * 64, I5 = 32 * 64, I6 = 32 * 352, I7 = 88 * 64;
    constexpr int NITEMS = I0 + I1 + I2 + I3 + I4 + I5 + I6;
    for (int it = gw; it < NITEMS; it += NGW) {
        int r = it;
        if (r < I6) { transpose_item(p.w_fi, 2 * DFF, nullptr, p.ws, 6, scr, r, lane); continue; } r -= I6;
        if (r < I0) { transpose_item(p.w_in, INW, nullptr, p.ws, 0, scr, r, lane); continue; } r -= I0;
        if (r < I5) { transpose_item(p.w_out, DM, nullptr, p.ws, 5, scr, r, lane); continue; } r -= I5;
        if (r < I3) { transpose_item(p.w_ba, DM, nullptr, p.ws, 3, scr, r, lane); continue; } r -= I3;
        if (r < I4) { transpose_item(p.w_bb, DM, nullptr, p.ws, 4, scr, r, lane); continue; } r -= I4;
        if (r < I1) { transpose_item(p.w_uq, 1536, p.qn, p.ws, 1, scr, r, lane); continue; } r -= I1;
        transpose_item(p.w_ukv, 2048, p.kvn, p.ws, 2, scr, r, lane);
    }
    const int gt = blockIdx.x * NTHR + tid, NGT = gridDim.x * NTHR;
    { const f32x4* xs = (const f32x4*)p.x; u32x4* xd = (u32x4*)(p.ws + WS_XB);
      for (int i0 = gt; i0 < T * DM / 8; i0 += 4 * NGT) { f32x4 a[4], b[4];
#pragma unroll
          for (int u = 0; u < 4; ++u) { const int i = i0 + u * NGT; a[u] = xs[2 * i]; b[u] = xs[2 * i + 1]; }
#pragma unroll
          for (int u = 0; u < 4; ++u) { const int i = i0 + u * NGT; xd[i] = pack8(a[u], b[u]); } } }
    { float* rt = (float*)(p.ws + WS_ROPE);
      for (int i = gt; i < SEQ * 32; i += NGT) { const int pos = i >> 5, k = i & 31; const float ang = (float)pos * p.inv_freq[k];
          double rev = (double)ang * 0.15915494309189535; rev -= floor(rev); const float rv = (float)rev;
          rt[2 * i] = __builtin_amdgcn_cosf(rv); rt[2 * i + 1] = __builtin_amdgcn_sinf(rv); } }
}

__device__ __forceinline__ float wave_sum(float v) {
#pragma unroll
    for (int o = 1; o < 64; o <<= 1) v += __shfl_xor(v, o);
    return v;
}
template <bool BF> __device__ __forceinline__ void ln_rows(const float* in, const float* g, const float* b, float* outf, bf16_t* outb, int wid, int lane) {
    const int gw = blockIdx.x * NWAVES + wid, NGW = gridDim.x * NWAVES;
    for (int row = gw; row < T; row += NGW) {
        const f32x4* xr = (const f32x4*)(in + (size_t)row * DM) + 2 * lane;
        f32x4 v[8]; float s = 0.f;
#pragma unroll
        for (int j = 0; j < 4; ++j) { v[2 * j] = xr[128 * j]; v[2 * j + 1] = xr[128 * j + 1]; }
#pragma unroll
        for (int j = 0; j < 8; ++j) s += (v[j][0] + v[j][1]) + (v[j][2] + v[j][3]);
        const float mean = wave_sum(s) * (1.f / DM); float s2 = 0.f;
#pragma unroll
        for (int j = 0; j < 8; ++j) { v[j] = v[j] - mean; s2 += (v[j][0] * v[j][0] + v[j][1] * v[j][1]) + (v[j][2] * v[j][2] + v[j][3] * v[j][3]); }
        const float rstd = 1.0f / sqrtf(wave_sum(s2) * (1.f / DM) + 1e-5f);
#pragma unroll
        for (int j = 0; j < 4; ++j) { const int c = 512 * j + 8 * lane;
            const f32x4 g0 = *(const f32x4*)(g + c), g1 = *(const f32x4*)(g + c + 4), b0 = *(const f32x4*)(b + c), b1 = *(const f32x4*)(b + c + 4);
            const f32x4 y0 = v[2 * j] * rstd * g0 + b0, y1 = v[2 * j + 1] * rstd * g1 + b1;
            if (BF) *(u32x4*)(outb + (size_t)row * DM + c) = pack8(y0, y1);
            else { *(f32x4*)(outf + (size_t)row * DM + c) = y0; *(f32x4*)(outf + (size_t)row * DM + c + 4) = y1; } }
        if (BF && lane == 0) { outf[2 * row] = mean; outf[2 * row + 1] = rstd; }
    }
}

template <int KROW> __device__ __forceinline__ int kswz(int row, int cc) { return KROW == 192 ? ((cc & ~7) | ((cc ^ (row >> 1)) & 7)) : (cc ^ (row & 15)); }

#ifndef QKA
#define QKA 2
#endif
#ifndef PVA
#define PVA 3
#endif
template <int KROW, int ND>
__device__ __forceinline__ void attn_core(const bf16_t* __restrict__ Qw  , const bf16_t* __restrict__ Kg, int kstride, const bf16_t* __restrict__ Vt,
                                          int qmin  , int NT, int kcol0, LAS unsigned char* lds, f32x16 (&o)[4], int tid_in) {
    constexpr int KCH = KROW / 8, KBYTES = 64 * KROW * 2, VBYTES = 128 * 128, STAGE = KBYTES + VBYTES, NKI = KBYTES / 1024 / NWAVES;
    static_assert(2 * STAGE <= 131072 && KBYTES % (1024 * NWAVES) == 0, "attention LDS");
    int tid = tid_in; asm volatile("" : "+v"(tid));
    const int lane = tid & 63, wid = __builtin_amdgcn_readfirstlane(tid >> 6), r32 = lane & 31, hi = lane >> 5;
    bf16x8 qf[ND];
#pragma unroll
    for (int dd = 0; dd < ND; ++dd) qf[dd] = *(const bf16x8*)(Qw + 16 * dd);
    unsigned kog[NKI], vog[2];
#pragma unroll
    for (int i = 0; i < NKI; ++i) { const int q = (wid * NKI + i) * 64 + lane, row = q / KCH, ccp = q % KCH; kog[i] = (unsigned)(row * kstride + kswz<KROW>(row, ccp) * 8) * 2u; }
#pragma unroll
    for (int i = 0; i < 2; ++i) { const int q = (wid * 2 + i) * 64 + lane, d = q >> 3, ccp = q & 7; vog[i] = (unsigned)(d * 4096 + (ccp ^ ((d >> 1) & 7)) * 8) * 2u; }
#define ATT_DMA(j, buf) do { const char* kb_ = (const char*)Kg + (size_t)(64 * (j)) * kstride * 2; const char* vb_ = (const char*)Vt + (size_t)(64 * (j)) * 2; \
        _Pragma("unroll") for (int i = 0; i < NKI; ++i) __builtin_amdgcn_global_load_lds((const unsigned*)(kb_ + kog[i]), (LAS unsigned*)(lds + (buf) * STAGE + (wid * NKI + i) * 1024), 16, 0, 0); \
        _Pragma("unroll") for (int i = 0; i < 2; ++i) __builtin_amdgcn_global_load_lds((const unsigned*)(vb_ + vog[i]), (LAS unsigned*)(lds + (buf) * STAGE + KBYTES + (wid * 2 + i) * 1024), 16, 0, 0); } while (0)
    const int prow = ((r32 & ~12) | ((r32 & 4) << 1) | ((r32 & 8) >> 1));
    int koffs[4], voffs[4]; const unsigned lds0 = (unsigned)(uintptr_t)lds;
#pragma unroll
    for (int m = 0; m < 4; ++m) {
        koffs[m] = (int)lds0 + prow * KROW * 2 + 16 * (KROW == 192 ? (kcol0 + ((2 * m + hi) ^ ((prow >> 1) & 7))) : ((kcol0 ^ (prow & 8)) + ((2 * m + hi) ^ (prow & 7))));
        voffs[m] = (int)lds0 + KBYTES + r32 * 128 + 16 * ((2 * m + hi) ^ ((r32 >> 1) & 7)); }
    float mrun = -INFINITY, lrun = 0.f;
#pragma unroll
    for (int d0 = 0; d0 < 4; ++d0)
#pragma unroll
        for (int r = 0; r < 16; ++r) o[d0][r] = 0.f;
    const int qg = qmin + r32, qmaxw = qmin + 31;
#define DSR(dst, addr, off) asm volatile("ds_read_b128 %0, %1 offset:%2" : "=&v"(dst) : "v"(addr), "n"(off))
#define LGK2(K, x, y) asm volatile("s_waitcnt lgkmcnt(%2)" : "+v"(x), "+v"(y) : "n"(K))
#define LGK1(K, x) asm volatile("s_waitcnt lgkmcnt(%1)" : "+v"(x) : "n"(K))
#define QKLOAD(dd, buf) do { DSR(ka[dd], koffs[(dd) & 3], (buf) * STAGE + 128 * ((dd) >> 2)); DSR(kb[dd], koffs[(dd) & 3], (buf) * STAGE + 128 * ((dd) >> 2) + 32 * KROW * 2); } while (0)
#define QKSTEP(dd, buf) do { if ((dd) + 2 < ND) QKLOAD(((dd) + 2 < ND ? (dd) + 2 : 0), buf); \
        LGK2(((dd) + 2 < ND ? 4 : ((dd) + 1 < ND ? 2 : 0)), ka[dd], kb[dd]); \
        s0 = __builtin_amdgcn_mfma_f32_32x32x16_bf16(ka[dd], qf[dd], s0, 0, 0, 0); s1 = __builtin_amdgcn_mfma_f32_32x32x16_bf16(kb[dd], qf[dd], s1, 0, 0, 0); } while (0)
#define PVLOAD(i, buf) DSR(vf[i], voffs[(i) >> 2], (buf) * STAGE + ((i) & 3) * 4096)
#define PVSTEP(i, buf) do { if ((i) + 4 < 16) PVLOAD(((i) + 4 < 16 ? (i) + 4 : 0), buf); \
        LGK1((15 - (i) < 4 ? 15 - (i) : 4), vf[i]); \
        o[(i) & 3] = __builtin_amdgcn_mfma_f32_32x32x16_bf16(vf[i], pk[(i) >> 2], o[(i) & 3], 0, 0, 0); } while (0)
#define ATT_COMPUTE(j, buf) do { if (64 * (j) <= qmaxw) { \
        f32x16 s0, s1; \
        _Pragma("unroll") for (int r = 0; r < 16; ++r) { s0[r] = 0.f; s1[r] = 0.f; } \
        { bf16x8 ka[ND], kb[ND]; \
          QKLOAD(0, buf); QKLOAD(1, buf); \
          QKSTEP(0, buf); QKSTEP(1, buf); QKSTEP(2, buf); QKSTEP(3, buf); \
          if constexpr (ND == 12) { QKSTEP((ND == 12 ? 4 : 0), buf); QKSTEP((ND == 12 ? 5 : 0), buf); QKSTEP((ND == 12 ? 6 : 0), buf); QKSTEP((ND == 12 ? 7 : 0), buf); \
                                    QKSTEP((ND == 12 ? 8 : 0), buf); QKSTEP((ND == 12 ? 9 : 0), buf); QKSTEP((ND == 12 ? 10 : 0), buf); QKSTEP((ND == 12 ? 11 : 0), buf); } } \
        if (64 * (j) + 63 > qmin) { const int kb_ = 64 * (j) + 8 * hi; \
            _Pragma("unroll") for (int r = 0; r < 16; ++r) { const int kv = kb_ + 16 * (r >> 3) + (r & 7); if (kv > qg) s0[r] = -INFINITY; if (kv + 32 > qg) s1[r] = -INFINITY; } } \
        float mx = fmaxf(s0[0], s1[0]); \
        _Pragma("unroll") for (int r = 1; r < 16; ++r) mx = fmaxf(mx, fmaxf(s0[r], s1[r])); \
        mx = fmaxf(mx, __shfl_xor(mx, 32)); \
        if (__any(mx > mrun + 8.0f)) { \
            const float mnew = fmaxf(mrun, mx), al = __builtin_amdgcn_exp2f(mrun - mnew); mrun = mnew; lrun *= al; \
            _Pragma("unroll") for (int d0 = 0; d0 < 4; ++d0) _Pragma("unroll") for (int r = 0; r < 16; ++r) o[d0][r] *= al; } \
        bf16x8 vf[16]; \
        PVLOAD(0, buf); PVLOAD(1, buf); PVLOAD(2, buf); PVLOAD(3, buf); \
        float ps = 0.f; \
        _Pragma("unroll") for (int r = 0; r < 16; ++r) { s0[r] = __builtin_amdgcn_exp2f(s0[r] - mrun); s1[r] = __builtin_amdgcn_exp2f(s1[r] - mrun); ps += s0[r] + s1[r]; } \
        lrun += ps; \
        bf16x8 pk[4]; \
        { u32x4 w; \
          w.x = cvt_pk_bf16(s0[0], s0[1]); w.y = cvt_pk_bf16(s0[2], s0[3]); w.z = cvt_pk_bf16(s0[4], s0[5]); w.w = cvt_pk_bf16(s0[6], s0[7]); pk[0] = __builtin_bit_cast(bf16x8, w); \
          w.x = cvt_pk_bf16(s0[8], s0[9]); w.y = cvt_pk_bf16(s0[10], s0[11]); w.z = cvt_pk_bf16(s0[12], s0[13]); w.w = cvt_pk_bf16(s0[14], s0[15]); pk[1] = __builtin_bit_cast(bf16x8, w); \
          w.x = cvt_pk_bf16(s1[0], s1[1]); w.y = cvt_pk_bf16(s1[2], s1[3]); w.z = cvt_pk_bf16(s1[4], s1[5]); w.w = cvt_pk_bf16(s1[6], s1[7]); pk[2] = __builtin_bit_cast(bf16x8, w); \
          w.x = cvt_pk_bf16(s1[8], s1[9]); w.y = cvt_pk_bf16(s1[10], s1[11]); w.z = cvt_pk_bf16(s1[12], s1[13]); w.w = cvt_pk_bf16(s1[14], s1[15]); pk[3] = __builtin_bit_cast(bf16x8, w); } \
        PVSTEP(0, buf); PVSTEP(1, buf); PVSTEP(2, buf); PVSTEP(3, buf); PVSTEP(4, buf); PVSTEP(5, buf); PVSTEP(6, buf); PVSTEP(7, buf); \
        PVSTEP(8, buf); PVSTEP(9, buf); PVSTEP(10, buf); PVSTEP(11, buf); PVSTEP(12, buf); PVSTEP(13, buf); PVSTEP(14, buf); PVSTEP(15, buf); \
    } } while (0)
#define ATT_WAITBAR() do { asm volatile("s_waitcnt vmcnt(0) lgkmcnt(0)" ::: "memory"); __builtin_amdgcn_s_barrier(); asm volatile("" ::: "memory"); } while (0)
    ATT_DMA(0, 0); ATT_WAITBAR();
    for (int j = 0; j < NT; j += 2) {
        ATT_DMA(j + 1, 1);
        ATT_COMPUTE(j, 0);
        ATT_WAITBAR();
        if (j + 2 < NT) ATT_DMA(j + 2, 0);
        ATT_COMPUTE(j + 1, 1);
        ATT_WAITBAR();
    }
    lrun += __shfl_xor(lrun, 32);
    const float rl = 1.0f / lrun;
#pragma unroll
    for (int d0 = 0; d0 < 4; ++d0)
#pragma unroll
        for (int r = 0; r < 16; ++r) o[d0][r] *= rl;
#undef ATT_DMA
#undef ATT_COMPUTE
#undef DSR
#undef LGK1
#undef LGK2
#undef QKLOAD
#undef QKSTEP
#undef PVLOAD
#undef PVSTEP
#undef ATT_WAITBAR
}
__device__ __forceinline__ void attn_store(const f32x16 (&o)[4], bf16_t* orow, int hi) {
#pragma unroll
    for (int d0 = 0; d0 < 4; ++d0)
#pragma unroll
        for (int g = 0; g < 4; ++g) { u32x2 w; w.x = cvt_pk_bf16(o[d0][4 * g], o[d0][4 * g + 1]); w.y = cvt_pk_bf16(o[d0][4 * g + 2], o[d0][4 * g + 3]);
            *(u32x2*)(orow + 32 * d0 + 8 * g + 4 * hi) = w; }
}
__device__ __forceinline__ void attention_phase(const Params& p, LAS unsigned char* lds, int tid, int wid, int lane_unused) {
    const bf16_t* QM = (const bf16_t*)(p.ws + WS_QM); const bf16_t* KM = (const bf16_t*)(p.ws + WS_KM); const bf16_t* VMT = (const bf16_t*)(p.ws + WS_VMT);
    const bf16_t* QD = (const bf16_t*)(p.ws + WS_QD); const bf16_t* KD = (const bf16_t*)(p.ws + WS_KD); const bf16_t* VDT = (const bf16_t*)(p.ws + WS_VDT);
    bf16_t* MLAO = (bf16_t*)(p.ws + WS_MLAO); bf16_t* DIFO = (bf16_t*)(p.ws + WS_DIFO);
    const int G = gridDim.x;
#define LANE_FRESH() int t_ = tid; asm volatile("" : "+v"(t_)); const int r32 = t_ & 31, hi = (t_ >> 5) & 1
    for (int blk = blockIdx.x; blk < 256; blk += G) {
        const int v = (G % 8 == 0) ? (blk % 8) * 32 + blk / 8 : blk;
        const int bh = v >> 4, b = bh >> 3, h = bh & 7, slot0 = (v & 15) * 8;
        for (int si = 0; si < 8; ++si) {
            const int code = p.sched[slot0 + si];
            if (code == 255) break;
            f32x16 o[4];
            if (code < 32) {
                const int q0 = code * 256, qmin = q0 + 32 * wid;
                { LANE_FRESH();
                attn_core<192, 12>(QM + (size_t)(b * SEQ + qmin + r32) * 1536 + h * 192 + 8 * hi, KM + (size_t)b * SEQ * 1536 + h * 192, 1536,
                                   VMT + (size_t)(b * 1024 + h * 128) * 4096, qmin, (q0 + 256) >> 6, 0, lds, o, tid); }
                { LANE_FRESH(); attn_store(o, MLAO + (size_t)(b * SEQ + qmin + r32) * 1024 + h * 128, hi); }
            } else {
                const int q0 = (code - 32) * 128, map = wid >> 2, qmin = q0 + 32 * (wid & 3);
                { LANE_FRESH();
                attn_core<128, 4>(QD + (size_t)(b * SEQ + qmin + r32) * 1024 + h * 128 + map * 64 + 8 * hi, KD + (size_t)b * SEQ * 1024 + h * 128, 1024,
                                  VDT + (size_t)(b * 1024 + h * 128) * 4096, qmin, (q0 + 128) >> 6, 8 * map, lds, o, tid); }
                LANE_FRESH(); const int lane = t_ & 63;
                LAS float* xch = (LAS float*)lds + (size_t)(wid & 3) * 4096 + lane;
                if (map == 1) {
#pragma unroll
                    for (int d0 = 0; d0 < 4; ++d0)
#pragma unroll
                        for (int r = 0; r < 16; ++r) xch[(d0 * 16 + r) * 64] = o[d0][r];
                }
                __syncthreads();
                if (map == 0) {
                    const float lam = expf(wave_sum(p.lq1[lane] * p.lk1[lane])) - expf(wave_sum(p.lq2[lane] * p.lk2[lane])) + 0.2f;
                    float ss = 0.f;
#pragma unroll
                    for (int d0 = 0; d0 < 4; ++d0)
#pragma unroll
                        for (int r = 0; r < 16; ++r) { const float vv = o[d0][r] - lam * xch[(d0 * 16 + r) * 64]; o[d0][r] = vv; ss += vv * vv; }
                    ss += __shfl_xor(ss, 32);
                    const float rs = __builtin_amdgcn_rsqf(ss * (1.0f / 128.0f) + 1e-5f) * 0.8f;
#pragma unroll
                    for (int d0 = 0; d0 < 4; ++d0)
#pragma unroll
                        for (int g = 0; g < 4; ++g) { const f32x4 gv = *(const f32x4*)(p.subln + 32 * d0 + 8 * g + 4 * hi);
#pragma unroll
                            for (int e = 0; e < 4; ++e) o[d0][4 * g + e] *= rs * gv[e]; }
                    attn_store(o, DIFO + (size_t)(b * SEQ + qmin + r32) * 1024 + h * 128, hi);
                }
                __syncthreads();
            }
        }
    }
}


__device__ __forceinline__ float bf2f(bf16_t v) { return __uint_as_float(((unsigned)v) << 16); }
#ifndef STOPAT
#define STOPAT 99
#endif
#define DUMP_BEGIN() const size_t NTOT_ = (size_t)T * DM; for (size_t i_ = (size_t)blockIdx.x * NTHR + threadIdx.x; i_ < NTOT_; i_ += (size_t)gridDim.x * NTHR) { float acc_ = 0.f;
#define DUMP_BF(off, n) acc_ += bf2f(((const bf16_t*)(ws + (off)))[i_ % (size_t)(n)]);
#define DUMP_F32(off, n) acc_ += ((const float*)(ws + (off)))[i_ % (size_t)(n)];
#define DUMP_END() p.out[i_] = acc_; } return;

__device__ __forceinline__ void krope_phase(const Params& p, LAS unsigned char* lds, int tid, int wid, int lane) {
    const bf16_t* XB = (const bf16_t*)(p.ws + WS_XB); const bf16_t* WK = (const bf16_t*)(p.ws + WS_WIN) + (size_t)7168 * 2048;
    bf16_t* KM = (bf16_t*)(p.ws + WS_KM); const float* ROPE = (const float*)(p.ws + WS_ROPE);
    const int r32 = lane & 31, hi = lane >> 5;
    LAS float* red = (LAS float*)lds;
    for (int blk = blockIdx.x; blk < T / 32; blk += gridDim.x) {
        const bf16_t* ap = XB + (size_t)(blk * 32 + r32) * 2048 + wid * 256 + 8 * hi;
        const bf16_t* bp = WK + (size_t)r32 * 2048 + wid * 256 + 8 * hi;
        f32x16 c0, c1;
#pragma unroll
        for (int r = 0; r < 16; ++r) { c0[r] = 0.f; c1[r] = 0.f; }
#pragma unroll 4
        for (int dd = 0; dd < 16; ++dd) {
            const bf16x8 a = *(const bf16x8*)(ap + 16 * dd), b0 = *(const bf16x8*)(bp + 16 * dd), b1 = *(const bf16x8*)(bp + (size_t)32 * 2048 + 16 * dd);
            c0 = __builtin_amdgcn_mfma_f32_32x32x16_bf16(a, b0, c0, 0, 0, 0);
            c1 = __builtin_amdgcn_mfma_f32_32x32x16_bf16(a, b1, c1, 0, 0, 0);
        }
#pragma unroll
        for (int r = 0; r < 16; ++r) { const int row = (r & 3) + 8 * (r >> 2) + 4 * hi;
            red[(wid * 32 + row) * 64 + r32] = c0[r]; red[(wid * 32 + row) * 64 + 32 + r32] = c1[r]; }
        __syncthreads();
        { const int row = tid >> 4, c4 = (tid & 15) * 4; f32x4 v = {0.f, 0.f, 0.f, 0.f};
#pragma unroll
          for (int w = 0; w < 8; ++w) v += *(const LAS f32x4*)(red + (w * 32 + row) * 64 + c4);
          const int t = blk * 32 + row, pos = t & 4095;
          const f32x4 cs = *(const f32x4*)(ROPE + ((size_t)pos * 32 + (c4 >> 1)) * 2);
          const f32x4 o = rope4(v, cs); u32x2 w2; w2.x = cvt_pk_bf16(o[0], o[1]); w2.y = cvt_pk_bf16(o[2], o[3]);
#pragma unroll
          for (int h = 0; h < 8; ++h) *(u32x2*)(KM + ((size_t)t * 8 + h) * 192 + 128 + c4) = w2; }
        __syncthreads();
    }
}
#define XB_TMO      128
#define XB_XCNT(j)  (256  + 64 * (j))
#define XB_XSUB(j)  (1280 + 64 * (j))
#define XB_XGEN(j)  (2304 + 64 * (j))
#define XB_TOP      3328
#define XB_TOPGEN   3392
#define XCD_BAR_WORDS 3456
#define XB_SPIN_CAP (1u << 18)

__device__ __forceinline__ unsigned xb_ld(unsigned* p)              { return __hip_atomic_load(p, __ATOMIC_RELAXED, __HIP_MEMORY_SCOPE_AGENT); }
__device__ __forceinline__ unsigned xb_add(unsigned* p, unsigned v) { return __hip_atomic_fetch_add(p, v, __ATOMIC_RELAXED, __HIP_MEMORY_SCOPE_AGENT); }
__device__ __forceinline__ unsigned xb_xcc_id() { return (unsigned)__builtin_amdgcn_s_getreg((3 << 11) | 20) & 0xFu; }
#define XB_SPIN(cond, bar) do { unsigned _sp = 0; while (cond) { __builtin_amdgcn_s_sleep(1); \
    if ((++_sp & 255u) == 0u) { if (xb_ld(&(bar)[XB_TMO])) break; if (_sp > XB_SPIN_CAP) { atomicAdd(&(bar)[XB_TMO], 1u); break; } } } } while (0)

struct XcdBarrier {
    unsigned* bar; unsigned x;
    volatile LAS unsigned* st;
};

__device__ __forceinline__ XcdBarrier xcd_barrier_post(unsigned* bar, volatile LAS unsigned* st) {
    XcdBarrier b; b.bar = bar; b.x = xb_xcc_id(); b.st = st;
    if (threadIdx.x == 0) (void)xb_add(&bar[XB_XCNT(b.x)], 1u);
    return b;
}
__device__ __forceinline__ void xcd_barrier_complete(unsigned* bar, unsigned x, unsigned& nloc, unsigned& nx) {
    const unsigned G = gridDim.x * gridDim.y * gridDim.z;
    unsigned sum, cnt, mine, sp = 0u;
    for (;;) {
        sum = 0u; cnt = 0u; mine = 0u;
#pragma unroll
        for (unsigned j = 0; j < 16; ++j) { const unsigned c = xb_ld(&bar[XB_XCNT(j)]); sum += c; cnt += (c > 0u) ? 1u : 0u; mine = (j == x) ? c : mine; }
        if (sum == G) break;
        __builtin_amdgcn_s_sleep(1);
        if ((++sp & 255u) == 0u) { if (xb_ld(&bar[XB_TMO])) break; if (sp > XB_SPIN_CAP) { atomicAdd(&bar[XB_TMO], 1u); break; } }
    }
    nloc = mine > 0u ? mine : 1u; nx = cnt > 0u ? cnt : 1u;
}

__device__ __forceinline__ void xcd_barrier(const XcdBarrier& b) {
    asm volatile("s_waitcnt vmcnt(0)" ::: "memory");
    __syncthreads();
    if (threadIdx.x == 0) {
        unsigned* bar = b.bar;
        __builtin_amdgcn_s_waitcnt(0);
        unsigned nloc = b.st[0], nx = b.st[1];
        if (nloc == 0u) { xcd_barrier_complete(bar, b.x, nloc, nx); b.st[0] = nloc; b.st[1] = nx; }
        const unsigned old = xb_add(&bar[XB_XSUB(b.x)], 1u);
        const unsigned gen = old / nloc;
        if (old + 1u == (gen + 1u) * nloc) {
            __builtin_amdgcn_fence(__ATOMIC_RELEASE, "agent");
            asm volatile("s_waitcnt vmcnt(0)" ::: "memory");
            const unsigned og = xb_add(&bar[XB_TOP], 1u);
            const unsigned tg = og / nx;
            if (og + 1u == (tg + 1u) * nx) xb_add(&bar[XB_TOPGEN], 1u);
            else XB_SPIN(xb_ld(&bar[XB_TOPGEN]) == tg, bar);
            __builtin_amdgcn_fence(__ATOMIC_ACQUIRE, "agent");
            xb_add(&bar[XB_XGEN(b.x)], 1u);
            asm volatile("s_waitcnt vmcnt(0)" ::: "memory");
        } else {
            XB_SPIN(xb_ld(&bar[XB_XGEN(b.x)]) == gen, bar);
            __builtin_amdgcn_fence(__ATOMIC_ACQUIRE, "agent");
            asm volatile("s_waitcnt vmcnt(0)" ::: "memory");
        }
    }
    __syncthreads();
}

__global__ void __launch_bounds__(NTHR, 2) fwd_megakernel(Params p) {
    extern __shared__ __attribute__((aligned(16))) unsigned char lds_raw[];
    LAS unsigned char* lds = (LAS unsigned char*)lds_raw;
    cg::grid_group grid = cg::this_grid();
    volatile LAS unsigned* bst = (volatile LAS unsigned*)(lds + 131072);
    if (threadIdx.x == 0) { bst[0] = 0u; bst[1] = 0u; }
    __syncthreads();
    XcdBarrier bar = xcd_barrier_post((unsigned*)p.ws, bst);
#define GRID_SYNC() xcd_barrier(bar)
    if (p.ph_hi - p.ph_lo > 1) grid.sync();
#define IN(k) (p.ph_lo <= (k) && (k) < p.ph_hi)
    const int tid = threadIdx.x, lane = tid & 63, wid = __builtin_amdgcn_readfirstlane(tid >> 6);
    const int G = gridDim.x, c = blockIdx.x;
    unsigned char* ws = p.ws;
    bf16_t* XB = (bf16_t*)(ws + WS_XB);
    const float* ROPE = (const float*)(ws + WS_ROPE);

    if IN(0) prologue(p, lds, tid, wid, lane);
    if (IN(0) && IN(1)) GRID_SYNC();
    if IN(1) {
        pg8::SegOrder S; S.A0 = XB; S.B0 = (const bf16_t*)(ws + WS_WIN); S.nM0 = 32; S.nN0 = 28;
        S.A1 = (const bf16_t*)(ws + WS_WDV); S.B1 = XB; S.nM1 = 4; S.nN1 = 32; S.A2 = nullptr; S.B2 = nullptr; S.nM2 = 0; S.nN2 = 0; S.init(2048, G, c);
        EpiP1 E{(bf16_t*)(ws + WS_CQ), (bf16_t*)(ws + WS_CKV), (bf16_t*)(ws + WS_QD), (bf16_t*)(ws + WS_KD), (bf16_t*)(ws + WS_VDT), (bf16_t*)(ws + WS_GA), (bf16_t*)(ws + WS_GB),
                (bf16_t*)(ws + WS_KM), (float*)(ws + WS_SSQ), (float*)(ws + WS_SSKV), ROPE};
        pg8::gemm_phase(lds, S, E);
    }
    if (IN(1) && IN(2)) GRID_SYNC();
    if IN(2) {
        krope_phase(p, lds, tid, wid, lane);
        pg8::SegOrder S; S.A0 = (const bf16_t*)(ws + WS_CQ); S.B0 = (const bf16_t*)(ws + WS_WUQ); S.nM0 = 32; S.nN0 = 6;
        S.A1 = (const bf16_t*)(ws + WS_CKV); S.B1 = (const bf16_t*)(ws + WS_WUK); S.nM1 = 32; S.nN1 = 4;
        S.A2 = (const bf16_t*)(ws + WS_WUV); S.B2 = (const bf16_t*)(ws + WS_CKV); S.nM2 = 4; S.nN2 = 32; S.init(512, G, c);
        EpiP2 E{(bf16_t*)(ws + WS_QM), (bf16_t*)(ws + WS_KM), (bf16_t*)(ws + WS_VMT), (const float*)(ws + WS_SSQ), (const float*)(ws + WS_SSKV), ROPE};
        pg8::gemm_phase(lds, S, E);
    }
    if (IN(2) && IN(3)) GRID_SYNC();
    if IN(3) attention_phase(p, lds, tid, wid, lane);
    if (IN(3) && IN(4)) GRID_SYNC();
    if IN(4) {
        pg8::PairOrder S; S.A0 = (const bf16_t*)(ws + WS_MLAO); S.B0 = (const bf16_t*)(ws + WS_WBA); S.A1 = (const bf16_t*)(ws + WS_DIFO); S.B1 = (const bf16_t*)(ws + WS_WBB);
        S.nM = 32; S.nN = 8; S.init(1024, G, c);
        EpiP4 E{(const bf16_t*)(ws + WS_GA), (const bf16_t*)(ws + WS_GB), (float*)(ws + WS_TMP), (bf16_t*)(ws + WS_MIX)};
        pg8::gemm_phase(lds, S, E);
    }
    if (IN(4) && IN(5)) GRID_SYNC();
    if IN(5) {
        pg8::SegOrder S; S.A0 = (const bf16_t*)(ws + WS_MIX); S.B0 = (const bf16_t*)(ws + WS_WOUT); S.nM0 = 32; S.nN0 = 8;
        S.A1 = S.B1 = S.A2 = S.B2 = nullptr; S.nM1 = S.nN1 = S.nM2 = S.nN2 = 0; S.init(2048, G, c);
        EpiRes E{p.x, (float*)(ws + WS_PRE)};
        pg8::gemm_phase(lds, S, E);
    }
    if (IN(5) && IN(6)) GRID_SYNC();
    if IN(6) ln_rows<true>((const float*)(ws + WS_PRE), p.ln1g, p.ln1b, (float*)(ws + WS_SSQ), (bf16_t*)(ws + WS_H1B), wid, lane);
    if (IN(6) && IN(7)) GRID_SYNC();
    if IN(7) {
        pg8::SegOrder S; S.A0 = (const bf16_t*)(ws + WS_H1B); S.B0 = (const bf16_t*)(ws + WS_WFI); S.nM0 = 32; S.nN0 = 44;
        S.A1 = S.B1 = S.A2 = S.B2 = nullptr; S.nM1 = S.nN1 = S.nM2 = S.nN2 = 0; S.init(2048, G, c);
        EpiSwiGLU E{(bf16_t*)(ws + WS_ACT)};
        pg8::gemm_phase(lds, S, E);
        { const int nfull = S.nwg % G, nidle = (nfull == 0) ? G : G - nfull, me = (nfull == 0) ? c : c - nfull;
          if (me >= 0) { LAS float* scr = (LAS float*)(lds + wid * 8704);
              for (int it = me * NWAVES + wid; it < 88 * 64; it += nidle * NWAVES) transpose_item(p.w_fd, DM, nullptr, p.ws, 7, scr, it, lane); } }
    }
    if (IN(7) && IN(8)) GRID_SYNC();
    if IN(8) {
        pg8::SegOrder S; S.A0 = (const bf16_t*)(ws + WS_ACT); S.B0 = (const bf16_t*)(ws + WS_WFD); S.nM0 = 32; S.nN0 = 8;
        S.A1 = S.B1 = S.A2 = S.B2 = nullptr; S.nM1 = S.nN1 = S.nM2 = S.nN2 = 0; S.init(DFF, G, c);
        EpiResLn E{(float*)(ws + WS_PRE), (const float*)(ws + WS_SSQ), p.ln1g, p.ln1b};
        pg8::gemm_phase(lds, S, E);
    }
    if (IN(8) && IN(9)) GRID_SYNC();
    if IN(9) ln_rows<false>((const float*)(ws + WS_PRE), p.ln2g, p.ln2b, p.out, nullptr, wid, lane);
}

extern "C" void kernel_launch(void* const* d_in, const int* in_sizes, int n_in, void* d_out, int out_size, void* d_ws, size_t ws_size, hipStream_t stream) {
    static int grid_blocks = 0;
    if (grid_blocks == 0) {
        if (n_in != 20 || in_sizes[0] != T * DM || out_size != T * DM || ws_size < WS_END) { fprintf(stderr, "kernel_launch: unexpected shapes (n_in %d, in0 %d, out %d, ws %zu)\n", n_in, n_in > 0 ? in_sizes[0] : -1, out_size, ws_size); grid_blocks = -1; return; }
        int dev = 0, cus = 0, per_cu = 0;
        (void)hipGetDevice(&dev);
        (void)hipDeviceGetAttribute(&cus, hipDeviceAttributeMultiprocessorCount, dev);
        if (hipFuncSetAttribute((const void*)fwd_megakernel, hipFuncAttributeMaxDynamicSharedMemorySize, LDS_BYTES) != hipSuccess) { fprintf(stderr, "kernel_launch: hipFuncSetAttribute failed\n"); grid_blocks = -1; return; }
        if (hipOccupancyMaxActiveBlocksPerMultiprocessor(&per_cu, (const void*)fwd_megakernel, NTHR, LDS_BYTES) != hipSuccess || per_cu < 1) { fprintf(stderr, "kernel_launch: occupancy query failed (%d)\n", per_cu); (void)hipGetLastError(); per_cu = 1; }
        grid_blocks = cus * (per_cu > 1 ? 1 : per_cu);
        if (grid_blocks > 256) grid_blocks = 256;
    }
    if (grid_blocks < 0) return;
    Params p{};
    p.x = (const float*)d_in[0]; p.w_in = (const float*)d_in[1]; p.qn = (const float*)d_in[2]; p.w_uq = (const float*)d_in[3]; p.kvn = (const float*)d_in[4]; p.w_ukv = (const float*)d_in[5];
    p.lq1 = (const float*)d_in[6]; p.lk1 = (const float*)d_in[7]; p.lq2 = (const float*)d_in[8]; p.lk2 = (const float*)d_in[9]; p.subln = (const float*)d_in[10];
    p.w_ba = (const float*)d_in[11]; p.w_bb = (const float*)d_in[12]; p.w_out = (const float*)d_in[13]; p.ln1g = (const float*)d_in[14]; p.ln1b = (const float*)d_in[15];
    p.w_fi = (const float*)d_in[16]; p.w_fd = (const float*)d_in[17]; p.ln2g = (const float*)d_in[18]; p.ln2b = (const float*)d_in[19];
    p.out = (float*)d_out; p.ws = (unsigned char*)d_ws;
    for (int i = 0; i < 32; ++i) p.inv_freq[i] = 1.0f / powf(10000.0f, (float)(2 * i) / 64.0f);
    {
        int code[48], cost[48], n = 0;
        for (int qb = 0; qb < 16; ++qb) { code[n] = qb; cost[n] = 6 * (qb + 1); ++n; }
        for (int qh = 0; qh < 32; ++qh) { code[n] = 32 + qh; cost[n] = 2 * (qh + 1); ++n; }
        for (int i = 0; i < n; ++i) for (int j = i + 1; j < n; ++j) if (cost[j] > cost[i]) { int t = cost[i]; cost[i] = cost[j]; cost[j] = t; t = code[i]; code[i] = code[j]; code[j] = t; }
        int load[16] = {0}, cnt[16] = {0};
        for (int i = 0; i < 128; ++i) p.sched[i] = 255;
        for (int i = 0; i < n; ++i) { int best = -1; for (int w = 0; w < 16; ++w) if (cnt[w] < 8 && (best < 0 || load[w] < load[best])) best = w;
            p.sched[best * 8 + cnt[best]++] = (unsigned char)code[i]; load[best] += cost[i]; }
    }
    if (hipMemsetAsync(d_ws, 0, 16384, stream) != hipSuccess) { fprintf(stderr, "kernel_launch: memset failed\n"); return; }
#ifndef MK_LAUNCHES
#define MK_LAUNCHES 1
#endif
    for (int li = 0; li < MK_LAUNCHES; ++li) {
        p.ph_lo = (MK_LAUNCHES == 1) ? 0 : li; p.ph_hi = (MK_LAUNCHES == 1) ? 10 : li + 1;
        void* args[] = {&p};
        hipError_t e = hipLaunchCooperativeKernel((const void*)fwd_megakernel, dim3(grid_blocks), dim3(NTHR), args, LDS_BYTES, stream);
        if (e != hipSuccess) { fprintf(stderr, "cooperative launch failed: %s (grid %d)\n", hipGetErrorString(e), grid_blocks); break; }
    }
}
```
